# Optimizing an MI355X kernel written in HIP

```python
import math
import jax
import jax.numpy as jnp
from jax import lax
import numpy as np

D_MODEL = 1024
BATCH = 8
SEQ = 4096
DEPTH = 2

GRID_W = 64
CTX_LEN = 256
HEAD_DIM = 64
EPS = 1e-6
ATTN_HEADS = 8
ATTN_KV_HEADS = 2
ATTN_GROUP = ATTN_HEADS // ATTN_KV_HEADS
ATTN_WIDTH = ATTN_HEADS * HEAD_DIM
ATTN_KV_WIDTH = ATTN_KV_HEADS * HEAD_DIM
Q_BLOCK = 128
ROPE_THETA = 10000.0
HYENA_WIDTH = 256
HYENA_ORDER = 2
HYENA_SHORT = 3
HYENA_BANDS = 16
HYENA_POS_DIM = 1 + 2 * HYENA_BANDS
HYENA_FILTER_HIDDEN = 64
HYENA_DECAY_TARGET = 1e-2
HYENA_FAST_DECAY = 0.3
HYENA_SLOW_DECAY = 1.5
RWKV_HEADS = 4
RWKV_WIDTH = RWKV_HEADS * HEAD_DIM
RWKV_DECAY_RANK = 64
RWKV_ICLR_RANK = 64
RWKV_GATE_RANK = 128
RWKV_GN_EPS = 64e-5
RWKV_SPLITS = (RWKV_WIDTH, RWKV_WIDTH, RWKV_WIDTH, 2 * RWKV_DECAY_RANK, 2 * RWKV_ICLR_RANK, RWKV_GATE_RANK)
RWKV_PROJ = 3 * RWKV_WIDTH + 2 * RWKV_DECAY_RANK + 2 * RWKV_ICLR_RANK + RWKV_GATE_RANK
LRU_WIDTH = 256
LRU_BLOCKS = 4
LRU_BLOCK = LRU_WIDTH // LRU_BLOCKS
LRU_CONV = 4
LRU_C = 8.0
N_BRANCH = 4
IN_SPLITS = (ATTN_WIDTH, ATTN_KV_WIDTH, ATTN_KV_WIDTH, 3 * HYENA_WIDTH, RWKV_PROJ, 2 * LRU_WIDTH, N_BRANCH * D_MODEL)
N_IN = ATTN_WIDTH + 2 * ATTN_KV_WIDTH + 3 * HYENA_WIDTH + RWKV_PROJ + 2 * LRU_WIDTH + N_BRANCH * D_MODEL
N_GROUPS = 4
EXPERTS_PER_GROUP = 4
N_EXPERTS = N_GROUPS * EXPERTS_PER_GROUP
TOP_K_INNER = 2
EXPERT_HIDDEN = 512

kernel_name = 'hybrid_gated_mixers_hmoe_dit'


def _rms(x, eps=EPS):
    xf = x.astype(jnp.float32)
    return (xf * lax.rsqrt(jnp.mean(xf * xf, -1, keepdims=True) + eps)).astype(x.dtype)


def _modulate(x, shift, scale):
    return _rms(x) * (1 + scale) + shift


def _split_cols(p, sizes):
    idx = np.cumsum(sizes)[:-1].tolist()
    return jnp.split(p, idx, axis=-1)


def _dwconv(x, w, b, pad_left):
    k = w.shape[0]
    y = lax.conv_general_dilated(x, w[:, None, :].astype(x.dtype), window_strides=(1,),
                                 padding=[(pad_left, k - 1 - pad_left)],
                                 dimension_numbers=('NWC', 'WIO', 'NWC'),
                                 feature_group_count=x.shape[-1])
    return y + b


def _axial_rope_tables(n_tokens):
    rows = n_tokens // GRID_W
    row = jnp.repeat(jnp.arange(rows), GRID_W)
    col = jnp.tile(jnp.arange(GRID_W), rows)
    n_freq = HEAD_DIM // 4
    freqs = ROPE_THETA ** (-jnp.arange(n_freq, dtype=jnp.float32) / n_freq)
    pos = jnp.stack([row, col], -1).astype(jnp.float32)
    ang = pos[..., None] * freqs
    return jnp.cos(ang), jnp.sin(ang)


def _apply_rope(x, cos, sin):
    shp = x.shape
    xf = x.astype(jnp.float32).reshape(shp[0], shp[1], -1, 2, 2, HEAD_DIM // 4)
    x1, x2 = xf[..., 0, :], xf[..., 1, :]
    cs, sn = cos[None, :, None], sin[None, :, None]
    out = jnp.stack([x1 * cs - x2 * sn, x1 * sn + x2 * cs], axis=-2)
    return out.reshape(shp).astype(x.dtype)


def _qkv_heads(p_q, p_k, p_v, q_gain, k_gain):
    b, l, _ = p_q.shape
    q = _rms(p_q.reshape(b, l, ATTN_KV_HEADS, ATTN_GROUP, HEAD_DIM)) * q_gain
    k = _rms(p_k.reshape(b, l, ATTN_KV_HEADS, HEAD_DIM)) * k_gain
    v = p_v.reshape(b, l, ATTN_KV_HEADS, HEAD_DIM)
    return q, k, v


def _attend(q, k, v):
    s = jnp.einsum('bqhgd,bkhd->bhgqk', q, k).astype(jnp.float32) * (HEAD_DIM ** -0.5)
    p = jax.nn.softmax(s, axis=-1).astype(v.dtype)
    o = jnp.einsum('bhgqk,bkhd->bqhgd', p, v)
    return o.reshape(o.shape[0], o.shape[1], -1)


def _attention_mixer(pc, px, q_gain, k_gain, need_ctx):
    qc, kc, vc = _qkv_heads(pc[0], pc[1], pc[2], q_gain, k_gain)
    qx, kx, vx = _qkv_heads(px[0], px[1], px[2], q_gain, k_gain)
    b, l = qx.shape[:2]
    cos, sin = _axial_rope_tables(l)
    qx = _apply_rope(qx, cos, sin)
    kx = _apply_rope(kx, cos, sin)
    k_all = jnp.concatenate([kc, kx], axis=1)
    v_all = jnp.concatenate([vc, vx], axis=1)
    n_blk = l // Q_BLOCK
    qb = jnp.moveaxis(qx.reshape(b, n_blk, Q_BLOCK, ATTN_KV_HEADS, ATTN_GROUP, HEAD_DIM), 1, 0)
    yb = lax.map(lambda q_blk: _attend(q_blk, k_all, v_all), qb)
    yx = jnp.moveaxis(yb, 0, 1).reshape(b, l, ATTN_WIDTH)
    yc = _attend(qc, kc, vc) if need_ctx else None
    return yc, yx


def _hyena_filters(n, f1, fb1, f2, fb2, f3):
    t = jnp.arange(n, dtype=jnp.float32) / n
    bands = jnp.arange(1, HYENA_BANDS + 1, dtype=jnp.float32)
    ang = 2.0 * math.pi * t[:, None] * bands
    feat = jnp.concatenate([t[:, None], jnp.sin(ang), jnp.cos(ang)], axis=-1)
    h = jnp.sin(feat @ f1.astype(jnp.float32) + fb1.astype(jnp.float32))
    h = jnp.sin(h @ f2.astype(jnp.float32) + fb2.astype(jnp.float32))
    h = (h @ f3.astype(jnp.float32)).reshape(n, HYENA_ORDER, 2, HYENA_WIDTH)
    deltas = jnp.linspace(-math.log(HYENA_DECAY_TARGET) / HYENA_SLOW_DECAY,
                          -math.log(HYENA_DECAY_TARGET) / HYENA_FAST_DECAY, HYENA_WIDTH, dtype=jnp.float32)
    h = h * jnp.exp(-t[:, None] * deltas)[:, None, None, :]
    return h / jnp.sum(jnp.abs(h), axis=(0, 2), keepdims=True)


def _two_sided_longconv(z, h_fwd, h_bwd, skip):
    n = z.shape[1]
    filt2l = jnp.concatenate([h_fwd, jnp.zeros_like(h_fwd[:1]), h_bwd[:0:-1]], axis=0)
    zf = jnp.fft.rfft(z.astype(jnp.float32), n=2 * n, axis=1)
    hf = jnp.fft.rfft(filt2l, n=2 * n, axis=0)
    y = jnp.fft.irfft(zf * hf[None], n=2 * n, axis=1)[:, :n]
    return (y + z.astype(jnp.float32) * skip.astype(jnp.float32)).astype(z.dtype)


def _hyena_mixer(pc, px, conv_w, conv_b, f1, fb1, f2, fb2, f3, skip, need_ctx):
    def run(p):
        z = _dwconv(p, conv_w, conv_b, HYENA_SHORT // 2)
        v, x1, x2 = jnp.split(z, 3, axis=-1)
        h = _hyena_filters(p.shape[1], f1, fb1, f2, fb2, f3)
        y = v
        for o, gate in enumerate((x1, x2)):
            y = gate * _two_sided_longconv(y, h[:, o, 0], h[:, o, 1], skip[o])
        return y
    return (run(pc) if need_ctx else None), run(px)


def _shift_mix(p, mu):
    prev = jnp.pad(p[:, :-1], ((0, 0), (1, 0), (0, 0)))
    nxt = jnp.pad(p[:, 1:], ((0, 0), (0, 1), (0, 0)))
    return p + (prev - p) * mu[0] + (nxt - p) * mu[1]


def _rwkv_heads(t):
    return t.reshape(t.shape[:-1] + (RWKV_HEADS, HEAD_DIM))


def _rwkv_inputs(p, mu, w0, w2, a0, a2, g2, k_k, k_a):
    b, l, _ = p.shape
    r, k, v, w1, a1, g1 = _split_cols(_shift_mix(p, mu), RWKV_SPLITS)
    w1 = w1.reshape(b, l, 2, RWKV_DECAY_RANK)
    a1 = a1.reshape(b, l, 2, RWKV_ICLR_RANK)
    w = -jax.nn.softplus(-(w0 + jnp.einsum('bldr,drc->bldc', jnp.tanh(w1), w2))) - 0.5
    decay = _rwkv_heads(jnp.exp(-jnp.exp(w.astype(jnp.float32))))
    a = _rwkv_heads(jax.nn.sigmoid(a0 + jnp.einsum('bldr,drc->bldc', a1, a2)))
    g = jax.nn.sigmoid(g1) @ g2
    kk = _rwkv_heads(k * k_k).astype(jnp.float32)
    kk = kk * lax.rsqrt(jnp.sum(kk * kk, -1, keepdims=True) + 1e-12)
    k_dir = _rwkv_heads(k)[:, :, None] * (1 + (a - 1) * _rwkv_heads(k_a))
    return _rwkv_heads(r), _rwkv_heads(v), kk, g, decay, a, k_dir


def _rwkv_scan(s0, r, decay, k, v, kk, a, reverse, emit):
    def step(s, inp):
        r_t, w_t, k_t, v_t, kk_t, a_t = inp
        s = (s * w_t[:, :, None, :]
             - jnp.einsum('bhvk,bhk->bhv', s, kk_t)[..., None] * (kk_t * a_t)[:, :, None, :]
             + v_t[..., None] * k_t[:, :, None, :])
        return s, (jnp.einsum('bhvk,bhk->bhv', s, r_t) if emit else None)
    xs = tuple(jnp.moveaxis(t.astype(jnp.float32), 1, 0) for t in (r, decay, k, v, kk, a))
    s_fin, ys = lax.scan(step, s0, xs, reverse=reverse)
    return s_fin, (jnp.moveaxis(ys, 0, 1) if emit else None)


def _rwkv_readout(y, r, k_dir, v, g, r_k, ln_w, ln_b):
    b, l = y.shape[:2]
    mu = jnp.mean(y, -1, keepdims=True)
    var = jnp.mean(jnp.square(y - mu), -1, keepdims=True)
    yn = ((y - mu) * lax.rsqrt(var + RWKV_GN_EPS)).reshape(b, l, RWKV_WIDTH) * ln_w + ln_b
    bonus = jnp.sum(jnp.sum(r[:, :, None] * k_dir * r_k, -1, keepdims=True) * v[:, :, None], axis=2)
    return ((yn + bonus.reshape(b, l, RWKV_WIDTH)) * g).astype(g.dtype)


def _rwkv_mixer(pc, px, mu, w0, w2, a0, a2, g2, k_k, k_a, r_k, ln_w, ln_b, need_ctx):
    rc, vc, kkc, gc, dc, ac, kdc = _rwkv_inputs(pc, mu, w0, w2, a0, a2, g2, k_k, k_a)
    rx, vx, kkx, gx, dx, ax, kdx = _rwkv_inputs(px, mu, w0, w2, a0, a2, g2, k_k, k_a)
    s0 = jnp.zeros((px.shape[0], RWKV_HEADS, HEAD_DIM, HEAD_DIM), jnp.float32)
    yc = 0.0
    yx = 0.0
    for d, rev in enumerate((False, True)):
        s_ctx, yc_d = _rwkv_scan(s0, rc, dc[:, :, d], kdc[:, :, d], vc, kkc, ac[:, :, d], rev, need_ctx)
        _, yx_d = _rwkv_scan(s_ctx, rx, dx[:, :, d], kdx[:, :, d], vx, kkx, ax[:, :, d], rev, True)
        yx = yx + yx_d
        if need_ctx:
            yc = yc + yc_d
    out_x = _rwkv_readout(yx, rx, kdx, vx, gx, r_k, ln_w, ln_b)
    out_c = _rwkv_readout(yc, rc, kdc, vc, gc, r_k, ln_w, ln_b) if need_ctx else None
    return out_c, out_x


def _blockdiag(x, w, b):
    bsz, l, _ = x.shape
    y = jnp.einsum('blnc,ncd->blnd', x.reshape(bsz, l, LRU_BLOCKS, LRU_BLOCK), w)
    return y.reshape(bsz, l, LRU_WIDTH) + b


def _lru_coeffs(xc, wa, ba, wx, bx, lam):
    r = jax.nn.sigmoid(_blockdiag(xc, wa, ba)).astype(jnp.float32)
    i = jax.nn.sigmoid(_blockdiag(xc, wx, bx)).astype(jnp.float32)
    log_a = -LRU_C * r * jax.nn.softplus(-lam.astype(jnp.float32))
    a = jnp.exp(log_a)
    b = jnp.sqrt(-jnp.expm1(2.0 * log_a)) * (i * xc.astype(jnp.float32))
    return a, b


def _linear_scan(a, b, h0, reverse):
    def combine(e1, e2):
        a1, b1 = e1
        a2, b2 = e2
        return a1 * a2, a2 * b1 + b2
    a_cum, b_cum = lax.associative_scan(combine, (a, b), axis=1, reverse=reverse)
    return a_cum * h0[:, None] + b_cum


def _lru_mixer(pc, px, conv_w, conv_b, wa, ba, wx, bx, lam, need_ctx):
    gate_c, xin_c = jnp.split(pc, 2, axis=-1)
    gate_x, xin_x = jnp.split(px, 2, axis=-1)
    pad = (LRU_CONV - 1) // 2
    xc_c = _dwconv(xin_c, conv_w, conv_b, pad)
    xc_x = _dwconv(xin_x, conv_w, conv_b, pad)
    h_init = jnp.zeros((px.shape[0], LRU_WIDTH), jnp.float32)
    yc = 0.0
    yx = 0.0
    for d, rev in enumerate((False, True)):
        a_c, b_c = _lru_coeffs(xc_c, wa[d], ba[d], wx[d], bx[d], lam[d])
        h_c = _linear_scan(a_c, b_c, h_init, rev)
        a_x, b_x = _lru_coeffs(xc_x, wa[d], ba[d], wx[d], bx[d], lam[d])
        h_x = _linear_scan(a_x, b_x, h_c[:, 0] if rev else h_c[:, -1], rev)
        yx = yx + h_x
        if need_ctx:
            yc = yc + h_c
    out_x = (yx * jax.nn.gelu(gate_x.astype(jnp.float32))).astype(px.dtype)
    out_c = (yc * jax.nn.gelu(gate_c.astype(jnp.float32))).astype(pc.dtype) if need_ctx else None
    return out_c, out_x


def _merge(gates, ys, w_brs, w_out):
    b, l, _ = gates.shape
    g = jax.nn.sigmoid(gates.reshape(b, l, N_BRANCH, D_MODEL))
    m = g[:, :, 0] * (ys[0] @ w_brs[0])
    for i in range(1, N_BRANCH):
        m = m + g[:, :, i] * (ys[i] @ w_brs[i])
    return m @ w_out


def _hier_moe(h, w_grp, b_grp, w_rt, b_rt, w1, w3, w2):
    shp = h.shape
    t = h.reshape(-1, D_MODEL)
    gp = jax.nn.softmax((t @ w_grp + b_grp).astype(jnp.float32), axis=-1)
    g_val, g_idx = lax.top_k(gp, 1)
    el = (t @ w_rt + b_rt).astype(jnp.float32).reshape(-1, N_GROUPS, EXPERTS_PER_GROUP)
    el = jnp.take_along_axis(el, g_idx[:, :, None], axis=1)[:, 0]
    e_val, e_idx = lax.top_k(jax.nn.softmax(el, axis=-1), TOP_K_INNER)
    wts = g_val * e_val / jnp.sum(e_val, -1, keepdims=True)
    e_glob = g_idx * EXPERTS_PER_GROUP + e_idx
    combine = jnp.sum(jax.nn.one_hot(e_glob, N_EXPERTS, dtype=jnp.float32) * wts[..., None], axis=1)
    combine = combine.astype(t.dtype)
    out = jnp.zeros_like(t)
    for e in range(N_EXPERTS):
        y = (jax.nn.silu(t @ w1[e]) * (t @ w3[e])) @ w2[e]
        out = out + combine[:, e:e + 1] * y
    return out.reshape(shp)


def setup_inputs(seed: int = 0) -> dict:
    key = jax.random.key(seed)
    keys = iter(jax.random.split(key, 64))
    f32 = jnp.float32

    def nrm(shape, scale):
        return jax.random.normal(next(keys), shape, f32) * scale

    d = D_MODEL
    fh = HYENA_FILTER_HIDDEN
    x = nrm((BATCH, SEQ, d), 1.0)
    c = nrm((BATCH, d), 1.0)
    ctx = nrm((BATCH, CTX_LEN, d), 1.0)
    c_ctx = nrm((d,), 1.0)
    ada_w = nrm((DEPTH, d, 6 * d), d ** -0.5)
    ada_b = nrm((DEPTH, 6 * d), 0.01)
    w_in = nrm((DEPTH, d, N_IN), d ** -0.5)
    q_norm = 1.0 + nrm((DEPTH, HEAD_DIM), 0.02)
    k_norm = 1.0 + nrm((DEPTH, HEAD_DIM), 0.02)
    hy_conv_w = nrm((DEPTH, HYENA_SHORT, 3 * HYENA_WIDTH), HYENA_SHORT ** -0.5)
    hy_conv_b = nrm((DEPTH, 3 * HYENA_WIDTH), 0.01)
    hy_f1 = nrm((DEPTH, HYENA_POS_DIM, fh), HYENA_POS_DIM ** -0.5)
    hy_fb1 = nrm((DEPTH, fh), 0.01)
    hy_f2 = nrm((DEPTH, fh, fh), fh ** -0.5)
    hy_fb2 = nrm((DEPTH, fh), 0.01)
    hy_f3 = nrm((DEPTH, fh, HYENA_ORDER * 2 * HYENA_WIDTH), fh ** -0.5)
    hy_skip = nrm((DEPTH, HYENA_ORDER, HYENA_WIDTH), 1.0)
    rw_mu = jax.random.uniform(next(keys), (DEPTH, 2, RWKV_PROJ), f32, 0.0, 0.5)
    n_pos = jnp.arange(RWKV_WIDTH, dtype=f32) / (RWKV_WIDTH - 1)
    ratio = jnp.arange(DEPTH, dtype=f32) / max(DEPTH - 1, 1)
    w0_sched = -7.0 + 5.0 * n_pos[None] ** (0.85 + ratio[:, None] ** 0.5) + 0.5
    rw_w0 = w0_sched[:, None, :] + nrm((DEPTH, 2, RWKV_WIDTH), 0.1)
    rw_w2 = nrm((DEPTH, 2, RWKV_DECAY_RANK, RWKV_WIDTH), 0.1 * RWKV_DECAY_RANK ** -0.5)
    rw_a0 = nrm((DEPTH, 2, RWKV_WIDTH), 0.1)
    rw_a2 = nrm((DEPTH, 2, RWKV_ICLR_RANK, RWKV_WIDTH), 0.1 * RWKV_ICLR_RANK ** -0.5)
    rw_g2 = nrm((DEPTH, RWKV_GATE_RANK, RWKV_WIDTH), RWKV_GATE_RANK ** -0.5)
    rw_k_k = 0.85 + nrm((DEPTH, RWKV_WIDTH), 0.02)
    rw_k_a = 1.0 + nrm((DEPTH, RWKV_WIDTH), 0.02)
    rw_r_k = nrm((DEPTH, RWKV_HEADS, HEAD_DIM), 0.1)
    rw_ln_w = 1.0 + nrm((DEPTH, RWKV_WIDTH), 0.02)
    rw_ln_b = nrm((DEPTH, RWKV_WIDTH), 0.01)
    lru_conv_w = nrm((DEPTH, LRU_CONV, LRU_WIDTH), LRU_CONV ** -0.5)
    lru_conv_b = nrm((DEPTH, LRU_WIDTH), 0.01)
    lru_wa = nrm((DEPTH, 2, LRU_BLOCKS, LRU_BLOCK, LRU_BLOCK), LRU_BLOCK ** -0.5)
    lru_ba = nrm((DEPTH, 2, LRU_WIDTH), 0.01)
    lru_wx = nrm((DEPTH, 2, LRU_BLOCKS, LRU_BLOCK, LRU_BLOCK), LRU_BLOCK ** -0.5)
    lru_bx = nrm((DEPTH, 2, LRU_WIDTH), 0.01)
    u = jax.random.uniform(next(keys), (DEPTH, 2, LRU_WIDTH), f32, 0.9, 0.999)
    sig = u ** (1.0 / LRU_C)
    lru_lambda = jnp.log(sig) - jnp.log1p(-sig)
    w_br_attn = nrm((DEPTH, ATTN_WIDTH, d), ATTN_WIDTH ** -0.5)
    w_br_hyena = nrm((DEPTH, HYENA_WIDTH, d), HYENA_WIDTH ** -0.5)
    w_br_rwkv = nrm((DEPTH, RWKV_WIDTH, d), RWKV_WIDTH ** -0.5)
    w_br_lru = nrm((DEPTH, LRU_WIDTH, d), LRU_WIDTH ** -0.5)
    w_out = nrm((DEPTH, d, d), d ** -0.5)
    moe_w_grp = nrm((DEPTH, d, N_GROUPS), d ** -0.5)
    moe_b_grp = nrm((DEPTH, N_GROUPS), 0.01)
    moe_w_rt = nrm((DEPTH, d, N_EXPERTS), d ** -0.5)
    moe_b_rt = nrm((DEPTH, N_EXPERTS), 0.01)
    moe_w1 = nrm((DEPTH, N_EXPERTS, d, EXPERT_HIDDEN), d ** -0.5)
    moe_w3 = nrm((DEPTH, N_EXPERTS, d, EXPERT_HIDDEN), d ** -0.5)
    moe_w2 = nrm((DEPTH, N_EXPERTS, EXPERT_HIDDEN, d), EXPERT_HIDDEN ** -0.5)
    return {'x': x, 'c': c, 'ctx': ctx, 'c_ctx': c_ctx, 'ada_w': ada_w, 'ada_b': ada_b, 'w_in': w_in,
            'q_norm': q_norm, 'k_norm': k_norm, 'hy_conv_w': hy_conv_w, 'hy_conv_b': hy_conv_b,
            'hy_f1': hy_f1, 'hy_fb1': hy_fb1, 'hy_f2': hy_f2, 'hy_fb2': hy_fb2, 'hy_f3': hy_f3,
            'hy_skip': hy_skip, 'rw_mu': rw_mu, 'rw_w0': rw_w0, 'rw_w2': rw_w2, 'rw_a0': rw_a0,
            'rw_a2': rw_a2, 'rw_g2': rw_g2, 'rw_k_k': rw_k_k, 'rw_k_a': rw_k_a, 'rw_r_k': rw_r_k,
            'rw_ln_w': rw_ln_w, 'rw_ln_b': rw_ln_b, 'lru_conv_w': lru_conv_w, 'lru_conv_b': lru_conv_b,
            'lru_wa': lru_wa, 'lru_ba': lru_ba, 'lru_wx': lru_wx, 'lru_bx': lru_bx, 'lru_lambda': lru_lambda,
            'w_br_attn': w_br_attn, 'w_br_hyena': w_br_hyena, 'w_br_rwkv': w_br_rwkv, 'w_br_lru': w_br_lru,
            'w_out': w_out, 'moe_w_grp': moe_w_grp, 'moe_b_grp': moe_b_grp, 'moe_w_rt': moe_w_rt,
            'moe_b_rt': moe_b_rt, 'moe_w1': moe_w1, 'moe_w3': moe_w3, 'moe_w2': moe_w2}


def reference(x, c, ctx, c_ctx, ada_w, ada_b, w_in, q_norm, k_norm, hy_conv_w, hy_conv_b,
              hy_f1, hy_fb1, hy_f2, hy_fb2, hy_f3, hy_skip, rw_mu, rw_w0, rw_w2, rw_a0, rw_a2,
              rw_g2, rw_k_k, rw_k_a, rw_r_k, rw_ln_w, rw_ln_b, lru_conv_w, lru_conv_b, lru_wa,
              lru_ba, lru_wx, lru_bx, lru_lambda, w_br_attn, w_br_hyena, w_br_rwkv, w_br_lru,
              w_out, moe_w_grp, moe_b_grp, moe_w_rt, moe_b_rt, moe_w1, moe_w3, moe_w2):
    for i in range(DEPTH):
        need_ctx = i < DEPTH - 1
        mod_x = (jax.nn.silu(c) @ ada_w[i] + ada_b[i])[:, None, :]
        mod_c = (jax.nn.silu(c_ctx) @ ada_w[i] + ada_b[i])[None, None, :]
        sh1x, sc1x, g1x, sh2x, sc2x, g2x = jnp.split(mod_x, 6, axis=-1)
        sh1c, sc1c, g1c, sh2c, sc2c, g2c = jnp.split(mod_c, 6, axis=-1)

        hx = _modulate(x, sh1x, sc1x)
        hc = _modulate(ctx, sh1c, sc1c)
        qx, kx, vx, hyx, rwx, lrx, gtx = _split_cols(hx @ w_in[i], IN_SPLITS)
        qc, kc, vc, hyc, rwc, lrc, gtc = _split_cols(hc @ w_in[i], IN_SPLITS)

        att_c, att_x = _attention_mixer((qc, kc, vc), (qx, kx, vx), q_norm[i], k_norm[i], need_ctx)
        hy_c, hy_x = _hyena_mixer(hyc, hyx, hy_conv_w[i], hy_conv_b[i], hy_f1[i], hy_fb1[i],
                                  hy_f2[i], hy_fb2[i], hy_f3[i], hy_skip[i], need_ctx)
        rw_c, rw_x = _rwkv_mixer(rwc, rwx, rw_mu[i], rw_w0[i], rw_w2[i], rw_a0[i], rw_a2[i], rw_g2[i],
                                 rw_k_k[i], rw_k_a[i], rw_r_k[i], rw_ln_w[i], rw_ln_b[i], need_ctx)
        lr_c, lr_x = _lru_mixer(lrc, lrx, lru_conv_w[i], lru_conv_b[i], lru_wa[i], lru_ba[i],
                                lru_wx[i], lru_bx[i], lru_lambda[i], need_ctx)
        w_brs = (w_br_attn[i], w_br_hyena[i], w_br_rwkv[i], w_br_lru[i])
        x = x + g1x * _merge(gtx, (att_x, hy_x, rw_x, lr_x), w_brs, w_out[i])

        moe_args = (moe_w_grp[i], moe_b_grp[i], moe_w_rt[i], moe_b_rt[i], moe_w1[i], moe_w3[i], moe_w2[i])
        if need_ctx:
            ctx = ctx + g1c * _merge(gtc, (att_c, hy_c, rw_c, lr_c), w_brs, w_out[i])
            n_ctx = ctx.shape[1]
            h2 = jnp.concatenate([_modulate(ctx, sh2c, sc2c), _modulate(x, sh2x, sc2x)], axis=1)
            f2 = _hier_moe(h2, *moe_args)
            ctx = ctx + g2c * f2[:, :n_ctx]
            x = x + g2x * f2[:, n_ctx:]
        else:
            x = x + g2x * _hier_moe(_modulate(x, sh2x, sc2x), *moe_args)
    return x
```

```cpp
#include <hip/hip_runtime.h>
#include <stdint.h>
#include <math.h>
#include <stdio.h>

typedef unsigned short bf16_t;
typedef short bf16x8 __attribute__((ext_vector_type(8)));
typedef float f32x4 __attribute__((ext_vector_type(4)));
typedef float f32x2 __attribute__((ext_vector_type(2)));
typedef short s16x4 __attribute__((ext_vector_type(4)));

#define NTHR 256
#define LDS_BYTES (73 * 1024)

constexpr int D = 1024, NB = 8, SEQ = 4096, CL = 256;
constexpr int TX = NB * SEQ;
constexpr int TC = NB * CL;
constexpr int T = TX + TC;
constexpr int NP = 3200;
constexpr int QO = 0, KO = 512, VO = 640, HYO = 768, RWO = 1536, LRO = 2688, GTO = 3200, NIN = 7296;
constexpr int NKEY = CL + SEQ;
constexpr int MAXROWS = 2 * T + 16 * 128;

constexpr size_t al(size_t x) { return (x + 255) & ~(size_t)255; }
constexpr size_t OFF_BAR = 0;
constexpr size_t OFF_CNT = 16384;
constexpr size_t OFF_CUSLOT = OFF_CNT + 1024;
constexpr size_t OFF_MOD = OFF_CNT + 16384;
constexpr size_t OFF_NORM = al(OFF_MOD + (size_t)2 * 9 * 6144 * 4);
constexpr size_t OFF_FH1 = al(OFF_NORM + 1024 * 4);
constexpr size_t OFF_FH2 = al(OFF_FH1 + (size_t)4352 * 64 * 4);
constexpr size_t OFF_FILT = al(OFF_FH2 + (size_t)4352 * 64 * 4);
constexpr size_t OFF_WIN = al(OFF_FILT + (size_t)4352 * 1024 * 4);
constexpr size_t OFF_WBR = al(OFF_WIN + (size_t)NIN * 1024 * 2);
constexpr size_t OFF_WOUT = al(OFF_WBR + (size_t)1024 * 1280 * 2);
constexpr size_t OFF_W13 = al(OFF_WOUT + (size_t)1024 * 1024 * 2);
constexpr size_t OFF_W2 = al(OFF_W13 + (size_t)16 * 1024 * 1024 * 2);
constexpr size_t OFF_HX = al(OFF_W2 + (size_t)16 * 1024 * 512 * 2);
constexpr size_t OFF_P = al(OFF_HX + (size_t)T * 1024 * 2);
constexpr size_t OFF_KB = al(OFF_P + (size_t)T * NP * 2);
constexpr size_t OFF_VT = al(OFF_KB + (size_t)16 * NKEY * 64 * 2);
constexpr size_t OFF_YRW = al(OFF_VT + (size_t)16 * NKEY * 64 * 2);
constexpr size_t OFF_RWOUT = al(OFF_YRW + (size_t)2 * T * 256 * 2);
constexpr size_t OFF_HF = al(OFF_RWOUT + (size_t)T * 256 * 2);
constexpr size_t OFF_HF1 = al(OFF_HF + (size_t)T * 256 * 2);
constexpr size_t OFF_CTXS = al(OFF_HF1 + (size_t)T * 256 * 2);
constexpr size_t OFF_RTE = al(OFF_CTXS + (size_t)TC * 1024 * 4);
constexpr size_t OFF_RTW = al(OFF_RTE + (size_t)T * 4);
constexpr size_t OFF_TOKPOS = al(OFF_RTW + (size_t)T * 8);
constexpr size_t OFF_ROWTOK = al(OFF_TOKPOS + (size_t)T * 8);
constexpr size_t OFF_LRAB = al(OFF_ROWTOK + (size_t)MAXROWS * 4);
constexpr size_t OFF_LRH0 = al(OFF_LRAB + (size_t)1024 * 128 * 4);
constexpr size_t OFF_ZTA = al(OFF_LRH0 + (size_t)1024 * 64 * 4);
constexpr size_t OFF_RWL = al(OFF_ZTA + (size_t)8 * 512 * 4096 * 2);
constexpr size_t OFF_WGH = al(OFF_RWL + (size_t)2 * 65536);
constexpr size_t WS_NEED = al(OFF_WGH + (size_t)1024 * 16 * 4);
static_assert(WS_NEED <= (size_t)536870912, "workspace must fit 512 MiB");
constexpr size_t OFF_RWE = OFF_W13;
constexpr size_t OFF_RWS0 = OFF_W2;
constexpr size_t OFF_H = OFF_P;
constexpr size_t OFF_Y2 = al(OFF_P + (size_t)MAXROWS * 512 * 2);
static_assert(OFF_Y2 + (size_t)MAXROWS * 1024 * 2 <= OFF_KB, "MoE buffers must fit inside P");

struct Params {
    const float* in[47];
    float* out;
    unsigned char* ws;
};

__device__ __forceinline__ float bf2f(bf16_t v) { return __uint_as_float(((unsigned)v) << 16); }
__device__ __forceinline__ bf16_t f2bf(float f) { return __builtin_bit_cast(bf16_t, (__bf16)f); }
typedef __bf16 bf16x2_t __attribute__((ext_vector_type(2)));
__device__ __forceinline__ unsigned pack2(float a, float b) { const f32x2 v = {a, b}; return __builtin_bit_cast(unsigned, __builtin_convertvector(v, bf16x2_t)); }
typedef unsigned u32x2_t __attribute__((ext_vector_type(2)));
__device__ __forceinline__ float wave_sum(float v) {
    v += __int_as_float(__builtin_amdgcn_update_dpp(0, __float_as_int(v), 0xB1, 0xf, 0xf, true));
    v += __int_as_float(__builtin_amdgcn_update_dpp(0, __float_as_int(v), 0x4E, 0xf, 0xf, true));
    v += __int_as_float(__builtin_amdgcn_update_dpp(0, __float_as_int(v), 0x141, 0xf, 0xf, true));
    v += __int_as_float(__builtin_amdgcn_update_dpp(0, __float_as_int(v), 0x140, 0xf, 0xf, true));
    const unsigned a = __float_as_uint(v);
    const u32x2_t r = __builtin_amdgcn_permlane16_swap(a, a, false, false);
    const float s = __uint_as_float(r[0]) + __uint_as_float(r[1]);
    const unsigned w = __float_as_uint(s);
    const u32x2_t q = __builtin_amdgcn_permlane32_swap(w, w, false, false);
    return __uint_as_float(q[0]) + __uint_as_float(q[1]);
}
__device__ __forceinline__ float sigmoidf_(float x) { return __builtin_amdgcn_rcpf(1.0f + __expf(-x)); }
__device__ __forceinline__ float tanh_fast(float x) { return 1.0f - 2.0f * __builtin_amdgcn_rcpf(1.0f + __expf(2.0f * x)); }
__device__ __forceinline__ float softplusf_(float x) { return x > 20.f ? x : log1pf(expf(x)); }

#define XB_TMO      128
#define XB_XCNT(j)  (256  + 64 * (j))
#define XB_XSUB(j)  (1280 + 64 * (j))
#define XB_XGEN(j)  (2304 + 64 * (j))
#define XB_TOP      3328
#define XB_TOPGEN   3392
#define XCD_BAR_WORDS 3456
#define XB_SPIN_CAP (1u << 22)
#define LAS __attribute__((address_space(3)))

__device__ __forceinline__ unsigned xb_ld(unsigned* p)              { return __hip_atomic_load(p, __ATOMIC_RELAXED, __HIP_MEMORY_SCOPE_AGENT); }
__device__ __forceinline__ unsigned xb_add(unsigned* p, unsigned v) { return __hip_atomic_fetch_add(p, v, __ATOMIC_RELAXED, __HIP_MEMORY_SCOPE_AGENT); }
__device__ __forceinline__ unsigned xb_xcc_id() { return (unsigned)__builtin_amdgcn_s_getreg((3 << 11) | 20) & 0xFu; }
#define XB_SPIN(cond, bar) do { unsigned _sp = 0; while (cond) { __builtin_amdgcn_s_sleep(1); \
    if ((++_sp & 255u) == 0u) { if (xb_ld(&(bar)[XB_TMO])) break; if (_sp > XB_SPIN_CAP) { atomicAdd(&(bar)[XB_TMO], 1u); break; } } } } while (0)

struct XcdBarrier { unsigned* bar; unsigned x; volatile LAS unsigned* st; };

__device__ __forceinline__ XcdBarrier xcd_barrier_post(unsigned* bar, volatile LAS unsigned* st) {
    XcdBarrier b; b.bar = bar; b.x = xb_xcc_id(); b.st = st;
    if (threadIdx.x == 0) (void)xb_add(&bar[XB_XCNT(b.x)], 1u);
    return b;
}
__device__ __forceinline__ void xcd_barrier_complete(unsigned* bar, unsigned x, unsigned& nloc, unsigned& nx) {
    const unsigned G = gridDim.x * gridDim.y * gridDim.z;
    unsigned sum, cnt, mine, sp = 0u;
    for (;;) {
        sum = 0u; cnt = 0u; mine = 0u;
#pragma unroll
        for (unsigned j = 0; j < 16; ++j) { const unsigned c = xb_ld(&bar[XB_XCNT(j)]); sum += c; cnt += (c > 0u) ? 1u : 0u; mine = (j == x) ? c : mine; }
        if (sum == G) break;
        __builtin_amdgcn_s_sleep(1);
        if ((++sp & 255u) == 0u) { if (xb_ld(&bar[XB_TMO])) break; if (sp > XB_SPIN_CAP) { atomicAdd(&bar[XB_TMO], 1u); break; } }
    }
    nloc = mine > 0u ? mine : 1u; nx = cnt > 0u ? cnt : 1u;
}
__device__ __forceinline__ void xcd_barrier(const XcdBarrier& b) {
    asm volatile("s_waitcnt vmcnt(0)" ::: "memory");
    __syncthreads();
    if (threadIdx.x == 0) {
        unsigned* bar = b.bar;
        __builtin_amdgcn_s_waitcnt(0);
        unsigned nloc = b.st[0], nx = b.st[1];
        if (nloc == 0u) { xcd_barrier_complete(bar, b.x, nloc, nx); b.st[0] = nloc; b.st[1] = nx; }
        const unsigned old = xb_add(&bar[XB_XSUB(b.x)], 1u);
        const unsigned gen = old / nloc;
        if (old + 1u == (gen + 1u) * nloc) {
            __builtin_amdgcn_fence(__ATOMIC_RELEASE, "agent");
            asm volatile("s_waitcnt vmcnt(0)" ::: "memory");
            const unsigned og = xb_add(&bar[XB_TOP], 1u);
            const unsigned tg = og / nx;
            if (og + 1u == (tg + 1u) * nx) xb_add(&bar[XB_TOPGEN], 1u);
            else XB_SPIN(xb_ld(&bar[XB_TOPGEN]) == tg, bar);
            __builtin_amdgcn_fence(__ATOMIC_ACQUIRE, "agent");
            xb_add(&bar[XB_XGEN(b.x)], 1u);
            asm volatile("s_waitcnt vmcnt(0)" ::: "memory");
        } else {
            XB_SPIN(xb_ld(&bar[XB_XGEN(b.x)]) == gen, bar);
            __builtin_amdgcn_fence(__ATOMIC_ACQUIRE, "agent");
            asm volatile("s_waitcnt vmcnt(0)" ::: "memory");
        }
    }
    __syncthreads();
}

__device__ __forceinline__ int tidx() { int t = threadIdx.x; asm volatile("" : "+v"(t)); return t; }

__device__ __forceinline__ void scan_pos(int b, int d, int pos, int& row, int& t, int& n) {
    if (pos < CL) { t = d ? (CL - 1 - pos) : pos; n = CL; row = TX + b * CL + t; }
    else { const int q = pos - CL; t = d ? (SEQ - 1 - q) : q; n = SEQ; row = b * SEQ + t; }
}
__device__ __forceinline__ int mod_row(int row) { return row < TX ? (row >> 12) : 8; }

template <int NI>
__device__ __forceinline__ void zero_acc(f32x4 (&acc)[NI][4]) {
#pragma unroll
    for (int ni = 0; ni < NI; ++ni)
#pragma unroll
        for (int mi = 0; mi < 4; ++mi) acc[ni][mi] = (f32x4){0.f, 0.f, 0.f, 0.f};
}

struct TileSched {
    int Nt, Px, x, rank, nblk, total;
    __device__ __forceinline__ TileSched(int Mt, int Nt_) {
        int bx = blockIdx.x, gd = gridDim.x; asm volatile("" : "+s"(bx), "+s"(gd));
        Nt = Nt_; x = bx & 7; rank = bx >> 3; nblk = (gd - x + 7) >> 3;
        Px = x < Mt ? (Mt - x + 7) >> 3 : 0; total = Px * Nt;
    }
    __device__ __forceinline__ void decode(int e, int& mt, int& nt) const {
        const int pg = 8 * Nt;
        int grp = e / pg; const int ngf = Px >> 3; if (grp > ngf) grp = ngf;
        const int r = e - grp * pg;
        const int gm = (Px - 8 * grp) < 8 ? (Px - 8 * grp) : 8;
        const int nbf = Nt >> 3;
        int nb = r / (gm * 8), w = 8, q2;
        if (nb >= nbf) { nb = nbf; w = Nt - 8 * nbf; q2 = r - nbf * gm * 8; } else q2 = r - nb * gm * 8;
        const int m_in = q2 / w, n_in = q2 - m_in * w;
        mt = x + 8 * (8 * grp + m_in); nt = 8 * nb + n_in;
    }
};

struct GCur { int e, mt, nt; };
template <class PH>
__device__ __forceinline__ bool gs_advance(const PH& ph, const TileSched& ts, GCur& c, bool first) {
    c.e = first ? ts.rank : c.e + ts.nblk;
    while (c.e < ts.total) { ts.decode(c.e, c.mt, c.nt); if (ph.valid(c.mt, c.nt)) return true; c.e += ts.nblk; }
    return false;
}
template <int NI, class PH>
__device__ __forceinline__ void gemm_stream(PH& ph, const TileSched& ts, unsigned char* lds) {
    constexpr int STG = 256 * 64;
    bf16_t* L = (bf16_t*)lds;
    const int tid = tidx(), lane = tid & 63, wid = tid >> 6, wr = wid >> 1, wc = wid & 1, lr = lane & 15, g = lane >> 4;
    const int crow = tid >> 3;
    const int kcs = ((tid & 7) ^ ((crow >> 1) & 7)) * 8;
    const int sw = (lr >> 1) & 7;
    const int p0 = (g ^ sw) << 3, p1 = ((g + 4) ^ sw) << 3;
    const int ao = (wr * 64 + lr) * 64, bo = (128 + wc * 16 * NI + lr) * 64;
    GCur lc; int lseg = 0, lkt = 0, lnk = 0; bool lex;
    const bf16_t *la0 = nullptr, *la1 = nullptr, *la2 = nullptr, *la3 = nullptr, *lb0 = nullptr; int lsb = 0;
    lex = !gs_advance(ph, ts, lc, true);
    if (lex) return;
#define GS_SETUP() do { lnk = ph.nk(lseg); \
        la0 = ph.arow(lc.mt, lc.nt, lseg, crow) + kcs; la1 = ph.arow(lc.mt, lc.nt, lseg, crow + 32) + kcs; \
        la2 = ph.arow(lc.mt, lc.nt, lseg, crow + 64) + kcs; la3 = ph.arow(lc.mt, lc.nt, lseg, crow + 96) + kcs; \
        lb0 = ph.brow(lc.mt, lc.nt, lseg, crow) + kcs; \
        lsb = __builtin_amdgcn_readfirstlane((int)(ph.brow(lc.mt, lc.nt, lseg, crow + 32) - ph.brow(lc.mt, lc.nt, lseg, crow))); } while (0)
#define GS_GLDS(gp, eo) __builtin_amdgcn_global_load_lds((const __attribute__((address_space(1))) unsigned*)(gp), (LAS unsigned*)(D_ + (eo)), 16, 0, 0)
#define GS_DMA(st) do { if (!lex) { const int ko = lkt * 64; bf16_t* D_ = L + (st) * STG + tid * 8; \
        GS_GLDS(la0 + ko, 0); GS_GLDS(la1 + ko, 2048); GS_GLDS(la2 + ko, 4096); GS_GLDS(la3 + ko, 6144); \
        GS_GLDS(lb0 + ko, 8192); GS_GLDS(lb0 + lsb + ko, 10240); \
        if (NI > 2) { GS_GLDS(lb0 + 2 * lsb + ko, 12288); GS_GLDS(lb0 + 3 * lsb + ko, 14336); } \
        if (++lkt == lnk) { lkt = 0; if (++lseg == ph.nseg) { lseg = 0; lex = !gs_advance(ph, ts, lc, false); } if (!lex) GS_SETUP(); } } } while (0)
#define GS_COMPUTE(st) do { const bf16_t* cur = L + (st) * STG; \
        _Pragma("unroll") for (int ks = 0; ks < 2; ++ks) { \
            const int pk = ks ? p1 : p0; \
            bf16x8 af[4], wf[NI]; \
            _Pragma("unroll") for (int mi = 0; mi < 4; ++mi) af[mi] = *(const bf16x8*)(cur + ao + mi * 16 * 64 + pk); \
            _Pragma("unroll") for (int ni = 0; ni < NI; ++ni) wf[ni] = *(const bf16x8*)(cur + bo + ni * 16 * 64 + pk); \
            __builtin_amdgcn_s_setprio(1); \
            _Pragma("unroll") for (int ni = 0; ni < NI; ++ni) \
                _Pragma("unroll") for (int mi = 0; mi < 4; ++mi) acc[ni][mi] = __builtin_amdgcn_mfma_f32_16x16x32_bf16(wf[ni], af[mi], acc[ni][mi], 0, 0, 0); \
            __builtin_amdgcn_s_setprio(0); \
        } } while (0)
    GS_SETUP();
    GCur cc = lc; int cseg = 0, ckt = 0, cnk = ph.nk(0);
    f32x4 acc[NI][4]; zero_acc<NI>(acc);
    __syncthreads();
    GS_DMA(0);
    GS_DMA(1);
    asm volatile("s_waitcnt vmcnt(0)" ::: "memory");
    __syncthreads();
#pragma unroll 1
    for (;;) {
        GS_COMPUTE(0);
        asm volatile("s_waitcnt vmcnt(0)" ::: "memory");
        __syncthreads();
        GS_DMA(0);
        GS_COMPUTE(1);
        asm volatile("s_waitcnt vmcnt(0)" ::: "memory");
        __syncthreads();
        GS_DMA(1);
        ckt += 2;
        if (ckt == cnk) {
            ph.seg_end(cc.mt, cc.nt, cseg, acc);
            ckt = 0;
            if (++cseg == ph.nseg) { cseg = 0; if (!gs_advance(ph, ts, cc, false)) break; }
            cnk = ph.nk(cseg);
        }
    }
    __syncthreads();
#undef GS_SETUP
#undef GS_GLDS
#undef GS_DMA
#undef GS_COMPUTE
}

__device__ __forceinline__ void phase_mod(const Params& p, unsigned char* lds) {
    float* s = (float*)lds;
    float* red = s + 9 * 1024;
    const int tid = tidx();
    const float* c = p.in[1]; const float* cc = p.in[3];
    for (int i = tid; i < 9 * 1024; i += NTHR) { const int r = i >> 10, k = i & 1023; const float v = r < 8 ? c[r * 1024 + k] : cc[k]; s[i] = v / (1.0f + expf(-v)); }
    __syncthreads();
    float* MOD = (float*)(p.ws + OFF_MOD);
    const int cg = tid & 31, kg = tid >> 5;
    for (int u = blockIdx.x; u < 2 * 6144 / 32; u += gridDim.x) {
        const int col = u * 32 + cg, l = col / 6144, j = col % 6144;
        const float* w = p.in[4] + (size_t)l * 1024 * 6144 + j;
        float acc[9];
#pragma unroll
        for (int r = 0; r < 9; ++r) acc[r] = 0.f;
        for (int k = kg * 128; k < kg * 128 + 128; ++k) {
            const float wv = w[(size_t)k * 6144];
#pragma unroll
            for (int r = 0; r < 9; ++r) acc[r] += s[r * 1024 + k] * wv;
        }
#pragma unroll
        for (int r = 0; r < 9; ++r) red[(kg * 32 + cg) * 9 + r] = acc[r];
        __syncthreads();
        for (int i = tid; i < 32 * 9; i += NTHR) {
            const int c2 = i / 9, r = i % 9; float a = 0.f;
#pragma unroll
            for (int q = 0; q < 8; ++q) a += red[(q * 32 + c2) * 9 + r];
            const int col2 = u * 32 + c2, l2 = col2 / 6144, j2 = col2 % 6144;
            MOD[(size_t)(l2 * 9 + r) * 6144 + j2] = a + p.in[5][l2 * 6144 + j2];
        }
        __syncthreads();
    }
}

__device__ __forceinline__ void tconv(const float* __restrict__ src, int K, int N, bf16_t* __restrict__ dst, int ldd, int coff, int mode, float* tile, int& ucnt) {
    const int tid = tidx();
    const int nkt = K >> 6, nnt = N >> 6, ntile = nkt * nnt;
    const int G_ = (int)gridDim.x;
    int first = ((int)blockIdx.x - ucnt % G_ + G_) % G_;
    ucnt += ntile;
    for (int tt = first; tt < ntile; tt += G_) {
        const int k0 = (tt / nnt) * 64, n0 = (tt % nnt) * 64;
        __syncthreads();
#pragma unroll
        for (int i = 0; i < 4; ++i) {
            const int q = tid + i * NTHR, r = q >> 4, c4 = (q & 15) * 4;
            const f32x4 v = *(const f32x4*)(src + (size_t)(k0 + r) * N + n0 + c4);
            tile[r * 65 + c4] = v[0]; tile[r * 65 + c4 + 1] = v[1]; tile[r * 65 + c4 + 2] = v[2]; tile[r * 65 + c4 + 3] = v[3];
        }
        __syncthreads();
#pragma unroll
        for (int i = 0; i < 2; ++i) {
            const int q = tid + i * NTHR, nl = q >> 3, kc8 = (q & 7) * 8, nn = n0 + nl;
            const int drow = mode == 0 ? nn : ((nn >> 4) * 32 + (mode == 2 ? 16 : 0) + (nn & 15));
            uint4 o;
            o.x = pack2(tile[(kc8 + 0) * 65 + nl], tile[(kc8 + 1) * 65 + nl]); o.y = pack2(tile[(kc8 + 2) * 65 + nl], tile[(kc8 + 3) * 65 + nl]);
            o.z = pack2(tile[(kc8 + 4) * 65 + nl], tile[(kc8 + 5) * 65 + nl]); o.w = pack2(tile[(kc8 + 6) * 65 + nl], tile[(kc8 + 7) * 65 + nl]);
            *(uint4*)(dst + (size_t)drow * ldd + coff + k0 + kc8) = o;
        }
    }
}
__device__ __forceinline__ void phase_wconv(const Params& p, int l, unsigned char* lds) {
    float* tile = (float*)lds;
    int ucnt = 0;
    tconv(p.in[6] + (size_t)l * 1024 * NIN, 1024, NIN, (bf16_t*)(p.ws + OFF_WIN), 1024, 0, 0, tile, ucnt);
    tconv(p.in[35] + (size_t)l * 512 * 1024, 512, 1024, (bf16_t*)(p.ws + OFF_WBR), 1280, 0, 0, tile, ucnt);
    tconv(p.in[36] + (size_t)l * 256 * 1024, 256, 1024, (bf16_t*)(p.ws + OFF_WBR), 1280, 512, 0, tile, ucnt);
    tconv(p.in[37] + (size_t)l * 256 * 1024, 256, 1024, (bf16_t*)(p.ws + OFF_WBR), 1280, 768, 0, tile, ucnt);
    tconv(p.in[38] + (size_t)l * 256 * 1024, 256, 1024, (bf16_t*)(p.ws + OFF_WBR), 1280, 1024, 0, tile, ucnt);
    tconv(p.in[39] + (size_t)l * 1024 * 1024, 1024, 1024, (bf16_t*)(p.ws + OFF_WOUT), 1024, 0, 0, tile, ucnt);
    tconv(p.in[21] + (size_t)(l * 2 + 0) * 64 * 256, 64, 256, (bf16_t*)(p.ws + OFF_RWL), 64, 0, 0, tile, ucnt);
    tconv(p.in[21] + (size_t)(l * 2 + 1) * 64 * 256, 64, 256, (bf16_t*)(p.ws + OFF_RWL) + 256 * 64, 64, 0, 0, tile, ucnt);
    tconv(p.in[22] + (size_t)l * 128 * 256, 128, 256, (bf16_t*)(p.ws + OFF_RWL) + 2 * 256 * 64, 128, 0, 0, tile, ucnt);
    __syncthreads();
}
__device__ __forceinline__ void phase_wconv_moe(const Params& p, int l, unsigned char* lds) {
    float* tile = (float*)lds;
    int ucnt = 0;
#pragma unroll 1
    for (int e = 0; e < 16; ++e) {
        tconv(p.in[44] + ((size_t)l * 16 + e) * 1024 * 512, 1024, 512, (bf16_t*)(p.ws + OFF_W13) + (size_t)e * 1024 * 1024, 1024, 0, 1, tile, ucnt);
        tconv(p.in[45] + ((size_t)l * 16 + e) * 1024 * 512, 1024, 512, (bf16_t*)(p.ws + OFF_W13) + (size_t)e * 1024 * 1024, 1024, 0, 2, tile, ucnt);
        tconv(p.in[46] + ((size_t)l * 16 + e) * 512 * 1024, 512, 1024, (bf16_t*)(p.ws + OFF_W2) + (size_t)e * 1024 * 512, 512, 0, 0, tile, ucnt);
    }
    __syncthreads();
}

__device__ __forceinline__ const float* stream_in_row(const Params& p, int l, int row) {
    if (row < TX) return (l == 0 ? p.in[0] : p.out) + (size_t)row * D;
    return (l == 0 ? p.in[2] : (const float*)(p.ws + OFF_CTXS)) + (size_t)(row - TX) * D;
}
__device__ __forceinline__ float* stream_out_row(const Params& p, int row) {
    if (row < TX) return p.out + (size_t)row * D;
    return (float*)(p.ws + OFF_CTXS) + (size_t)(row - TX) * D;
}

__device__ __forceinline__ void phase_hx(const Params& p, int l) {
    const int lane = tidx() & 63, gw = blockIdx.x * 4 + (tidx() >> 6), nw = gridDim.x * 4;
    bf16_t* HX = (bf16_t*)(p.ws + OFF_HX);
    const float* MOD = (const float*)(p.ws + OFF_MOD);
    for (int row0 = gw * 2; row0 < T; row0 += nw * 2) {
        f32x4 v[2][4]; float ss[2] = {0.f, 0.f};
#pragma unroll
        for (int rr = 0; rr < 2; ++rr) {
            const float* src = stream_in_row(p, l, row0 + rr);
#pragma unroll
            for (int i = 0; i < 4; ++i) v[rr][i] = *(const f32x4*)(src + i * 256 + lane * 4);
        }
#pragma unroll
        for (int rr = 0; rr < 2; ++rr) {
#pragma unroll
            for (int i = 0; i < 4; ++i) ss[rr] += v[rr][i][0] * v[rr][i][0] + v[rr][i][1] * v[rr][i][1] + v[rr][i][2] * v[rr][i][2] + v[rr][i][3] * v[rr][i][3];
            ss[rr] = wave_sum(ss[rr]);
        }
#pragma unroll
        for (int rr = 0; rr < 2; ++rr) {
            const int row = row0 + rr;
            const float rstd = rsqrtf(ss[rr] * (1.0f / 1024.0f) + 1e-6f);
            const float* mod = MOD + (size_t)(l * 9 + mod_row(row)) * 6144;
#pragma unroll
            for (int i = 0; i < 4; ++i) {
                const int k = i * 256 + lane * 4;
                const f32x4 sh = *(const f32x4*)(mod + k), sc = *(const f32x4*)(mod + 1024 + k);
                uint2 o;
                o.x = pack2(v[rr][i][0] * rstd * (1.f + sc[0]) + sh[0], v[rr][i][1] * rstd * (1.f + sc[1]) + sh[1]);
                o.y = pack2(v[rr][i][2] * rstd * (1.f + sc[2]) + sh[2], v[rr][i][3] * rstd * (1.f + sc[3]) + sh[3]);
                *(uint2*)(HX + (size_t)row * 1024 + k) = o;
            }
        }
    }
}

__device__ __forceinline__ void phase_hyf1(const Params& p, int l) {
    float* FH1 = (float*)(p.ws + OFF_FH1);
    const float* f1 = p.in[11] + (size_t)l * 33 * 64; const float* fb1 = p.in[12] + l * 64;
    for (int i = blockIdx.x * NTHR + tidx(); i < 4352 * 64; i += gridDim.x * NTHR) {
        const int r = i >> 6, j = i & 63;
        const float tau = r < 4096 ? (float)r * (1.0f / 4096.0f) : (float)(r - 4096) * (1.0f / 256.0f);
        float a = fb1[j] + tau * f1[j];
        for (int q = 0; q < 16; ++q) {
            const float ang = 2.0f * 3.14159265358979323846f * tau * (float)(q + 1);
            a += sinf(ang) * f1[(1 + q) * 64 + j] + cosf(ang) * f1[(17 + q) * 64 + j];
        }
        FH1[i] = sinf(a);
    }
}
__device__ __forceinline__ void phase_hyf2(const Params& p, int l) {
    const float* FH1 = (const float*)(p.ws + OFF_FH1); float* FH2 = (float*)(p.ws + OFF_FH2);
    const float* f2 = p.in[13] + (size_t)l * 64 * 64; const float* fb2 = p.in[14] + l * 64;
    for (int i = blockIdx.x * NTHR + tidx(); i < 4352 * 64; i += gridDim.x * NTHR) {
        const int r = i >> 6, j = i & 63;
        float a = fb2[j];
        for (int q = 0; q < 64; ++q) a += FH1[r * 64 + q] * f2[q * 64 + j];
        FH2[i] = sinf(a);
    }
}
__device__ __forceinline__ void phase_hyf3(const Params& p, int l, unsigned char* lds) {
    const float* FH2 = (const float*)(p.ws + OFF_FH2); float* F = (float*)(p.ws + OFF_FILT);
    const float* f3 = p.in[15] + (size_t)l * 64 * 1024;
    const float lo = 4.605170185988091f / 1.5f, hi = 4.605170185988091f / 0.3f;
    bf16_t* hs = (bf16_t*)lds;
    bf16_t* wT = hs + 64 * 72;
    const int tid = tidx(), lane = tid & 63, wid = tid >> 6, lr = lane & 15, g = lane >> 4;
    for (int u = blockIdx.x; u < 68 * 16; u += gridDim.x) {
        const int tt = u >> 4, ct = u & 15, r0 = tt * 64, col0 = ct * 64;
        __syncthreads();
        for (int i = tid; i < 2048; i += NTHR) {
            const int t = i >> 5, q2 = (i & 31) * 2;
            const float2 hv = *(const float2*)(FH2 + (size_t)(r0 + t) * 64 + q2);
            *(unsigned*)(hs + t * 72 + q2) = pack2(hv.x, hv.y);
            const int qq = (i >> 6) * 2, cl = i & 63;
            *(unsigned*)(wT + cl * 72 + qq) = pack2(f3[(size_t)qq * 1024 + col0 + cl], f3[(size_t)(qq + 1) * 1024 + col0 + cl]);
        }
        __syncthreads();
        const int col = col0 + wid * 16 + lr, c = col & 255;
        const float delta = lo + (hi - lo) * ((float)c * (1.0f / 255.0f));
        bf16x8 bf[2];
#pragma unroll
        for (int ks = 0; ks < 2; ++ks) bf[ks] = *(const bf16x8*)(wT + (wid * 16 + lr) * 72 + ks * 32 + g * 8);
#pragma unroll
        for (int rt = 0; rt < 4; ++rt) {
            f32x4 acc = {0.f, 0.f, 0.f, 0.f};
#pragma unroll
            for (int ks = 0; ks < 2; ++ks) acc = __builtin_amdgcn_mfma_f32_16x16x32_bf16(*(const bf16x8*)(hs + (rt * 16 + lr) * 72 + ks * 32 + g * 8), bf[ks], acc, 0, 0, 0);
            const int r = r0 + rt * 16 + 4 * g;
            const bool isx = r < 4096;
            const int t = isx ? r : r - 4096;
            const float ts = isx ? (1.0f / 4096.0f) : (1.0f / 256.0f);
            f32x4 o;
#pragma unroll
            for (int j = 0; j < 4; ++j) o[j] = acc[j] * __expf(-(float)(t + j) * ts * delta);
            *(f32x4*)(F + (isx ? (size_t)col * 4096 + t : (size_t)4096 * 1024 + (size_t)col * 256 + t)) = o;
        }
    }
    __syncthreads();
}
__device__ __forceinline__ void hy_norm_unit(const Params& p, int u, unsigned char* lds) {
    const float* F = (const float*)(p.ws + OFF_FILT); float* NORM = (float*)(p.ws + OFF_NORM);
    const int tid = tidx(), lane = tid & 63, id = u * 4 + (tid >> 6);
    const int var = id >> 9, o = (id >> 8) & 1, c = id & 255;
    const int n = var ? 256 : 4096;
    const float* f0 = F + (var ? (size_t)4096 * 1024 : 0) + (size_t)(o * 512 + c) * n;
    const float* f1 = f0 + (size_t)256 * n;
    float s = 0.f;
    for (int t = lane; t < n; t += 64) s += fabsf(f0[t]) + fabsf(f1[t]);
    s = wave_sum(s);
    if (lane == 0) NORM[id] = s;
}


struct PhInproj {
    const bf16_t* HX; const bf16_t* WIN; bf16_t* P; int l; int wr, wc, lr, g;
    static constexpr int nseg = 1;
    __device__ __forceinline__ bool valid(int mt, int nt) const { return !(l == 1 && mt >= 256 && !(nt == 4 || nt == 5 || nt >= 12)); }
    __device__ __forceinline__ int nk(int) const { return 16; }
    __device__ __forceinline__ const bf16_t* arow(int mt, int, int, int r) const { return HX + (size_t)(mt * 128 + r) * 1024; }
    __device__ __forceinline__ const bf16_t* brow(int, int nt, int, int r) const { return WIN + (size_t)(nt * 128 + r) * 1024; }
    __device__ __forceinline__ void seg_end(int mt, int nt, int, f32x4 (&acc)[4][4]) const {
#pragma unroll
        for (int ni = 0; ni < 4; ++ni)
#pragma unroll
            for (int mi = 0; mi < 4; ++mi) {
                const int m = mt * 128 + wr * 64 + mi * 16 + lr, n = nt * 128 + wc * 64 + ni * 16 + g * 4;
                uint2 o; o.x = pack2(acc[ni][mi][0], acc[ni][mi][1]); o.y = pack2(acc[ni][mi][2], acc[ni][mi][3]);
                *(uint2*)(P + (size_t)m * NP + n) = o;
                acc[ni][mi] = (f32x4){0.f, 0.f, 0.f, 0.f};
            }
    }
};
__device__ __forceinline__ void phase_inproj(const Params& p, int l, unsigned char* lds) {
    const int lane = tidx() & 63, wid = tidx() >> 6;
    PhInproj ph{(const bf16_t*)(p.ws + OFF_HX), (const bf16_t*)(p.ws + OFF_WIN), (bf16_t*)(p.ws + OFF_P), l, wid >> 1, wid & 1, lane & 15, lane >> 4};
    const TileSched ts_(272, 25);
    gemm_stream<4>(ph, ts_, lds);
}

__device__ __forceinline__ void phase_qk(const Params& p, int l) {
    bf16_t* P = (bf16_t*)(p.ws + OFF_P); bf16_t* KB = (bf16_t*)(p.ws + OFF_KB); bf16_t* VT = (bf16_t*)(p.ws + OFF_VT);
    const int lane = tidx() & 63, gw = blockIdx.x * 4 + (tidx() >> 6), nw = gridDim.x * 4;
    const float qg = p.in[7][l * 64 + lane], kg = p.in[8][l * 64 + lane];
    const float freq = exp2f(-(float)(lane & 15) * (13.287712379549449f / 16.0f));
    for (int row = gw; row < T; row += nw) {
        const bool isx = row < TX;
        const bool doq = isx || l == 0;
        int b, key, t = 0;
        if (isx) { b = row >> 12; t = row & 4095; key = CL + t; } else { const int rc = row - TX; b = rc >> 8; key = rc & 255; }
        bf16_t* pr = P + (size_t)row * NP + lane;
        bf16_t raw[12];
#pragma unroll
        for (int v = 0; v < 12; ++v) raw[v] = (v < 8 && !doq) ? (bf16_t)0 : pr[v * 64];
        float cs = 1.f, sn = 0.f;
        if (isx) { const float ang = ((lane < 32) ? (float)(t >> 6) : (float)(t & 63)) * freq; cs = cosf(ang); sn = sinf(ang); }
#pragma unroll
        for (int v = 0; v < 12; ++v) {
            if (v >= 10) { VT[((size_t)(b * 2 + (v - 10)) * 64 + lane) * NKEY + key] = raw[v]; continue; }
            if (v < 8 && !doq) continue;
            const float val = bf2f(raw[v]);
            const float ss = wave_sum(val * val);
            float nv = val * rsqrtf(ss * (1.0f / 64.0f) + 1e-6f) * (v < 8 ? qg : kg);
            if (isx) {
                const float partner = __shfl_xor(nv, 16);
                nv = ((lane >> 4) & 1) ? (partner * sn + nv * cs) : (nv * cs - partner * sn);
            }
            if (v < 8) pr[v * 64] = f2bf(nv * (0.125f * 1.4426950408889634f));
            else KB[((size_t)(b * 2 + (v - 8)) * NKEY + key) * 64 + lane] = f2bf(nv);
        }
    }
}

__device__ __forceinline__ void attn_tile_compute(const bf16_t* Ks, const bf16_t* Vs, const bf16x8 (&qf)[2][2], f32x4 (&o)[4][2], float negmb, float (&lrun)[2], int lr, int g) {
    f32x4 st[4][2];
#pragma unroll
    for (int ki = 0; ki < 4; ++ki) { st[ki][0] = (f32x4){negmb, negmb, negmb, negmb}; st[ki][1] = (f32x4){negmb, negmb, negmb, negmb}; }
#pragma unroll
    for (int ks = 0; ks < 2; ++ks)
#pragma unroll
        for (int ki = 0; ki < 4; ++ki) {
            const bf16x8 kf = *(const bf16x8*)(Ks + (ki * 16 + lr) * 72 + ks * 32 + g * 8);
            st[ki][0] = __builtin_amdgcn_mfma_f32_16x16x32_bf16(kf, qf[0][ks], st[ki][0], 0, 0, 0);
            st[ki][1] = __builtin_amdgcn_mfma_f32_16x16x32_bf16(kf, qf[1][ks], st[ki][1], 0, 0, 0);
        }
    bf16x8 pf[2][2];
#pragma unroll
    for (int mi = 0; mi < 2; ++mi) {
        float ps = 0.f;
#pragma unroll
        for (int ki = 0; ki < 4; ++ki)
#pragma unroll
            for (int j = 0; j < 4; ++j) { const float e = __builtin_amdgcn_exp2f(st[ki][mi][j]); st[ki][mi][j] = e; ps += e; }
        lrun[mi] += ps;
#pragma unroll
        for (int kb = 0; kb < 2; ++kb) {
            union { bf16x8 v; unsigned w[4]; } pk;
            pk.w[0] = pack2(st[2 * kb][mi][0], st[2 * kb][mi][1]); pk.w[1] = pack2(st[2 * kb][mi][2], st[2 * kb][mi][3]);
            pk.w[2] = pack2(st[2 * kb + 1][mi][0], st[2 * kb + 1][mi][1]); pk.w[3] = pack2(st[2 * kb + 1][mi][2], st[2 * kb + 1][mi][3]);
            pf[mi][kb] = pk.v;
        }
    }
#pragma unroll
    for (int di = 0; di < 4; ++di)
#pragma unroll
        for (int kb = 0; kb < 2; ++kb) {
            union { bf16x8 v; uint2 h[2]; } vf;
            const bf16_t* vr = Vs + (di * 16 + lr) * 72 + kb * 32 + g * 4;
            vf.h[0] = *(const uint2*)vr; vf.h[1] = *(const uint2*)(vr + 16);
            o[di][0] = __builtin_amdgcn_mfma_f32_16x16x32_bf16(vf.v, pf[0][kb], o[di][0], 0, 0, 0);
            o[di][1] = __builtin_amdgcn_mfma_f32_16x16x32_bf16(vf.v, pf[1][kb], o[di][1], 0, 0, 0);
        }
}

__device__ __forceinline__ void attn_unit(const Params& p, int l, int u, unsigned char* lds) {
    bf16_t* P = (bf16_t*)(p.ws + OFF_P);
    const bf16_t* KB = (const bf16_t*)(p.ws + OFF_KB); const bf16_t* VT = (const bf16_t*)(p.ws + OFF_VT);
    bf16_t* Ks = (bf16_t*)lds; bf16_t* Vs = Ks + 64 * 72;
    const int tid = tidx(), lane = tid & 63, wid = tid >> 6, lr = lane & 15, g = lane >> 4;
    int b, kvh, row0, nkeys;
    if (u < 2048) { b = u >> 8; kvh = (u >> 7) & 1; row0 = b * SEQ + (u & 127) * 32; nkeys = NKEY; }
    else { const int i = u - 2048; b = i >> 4; kvh = (i >> 3) & 1; row0 = TX + b * CL + (i & 7) * 32; nkeys = CL; }
    const int head = kvh * 4 + wid;
    bf16x8 qf[2][2];
#pragma unroll
    for (int mi = 0; mi < 2; ++mi)
#pragma unroll
        for (int ks = 0; ks < 2; ++ks) qf[mi][ks] = *(const bf16x8*)(P + (size_t)(row0 + mi * 16 + lr) * NP + head * 64 + ks * 32 + g * 8);
    f32x4 o[4][2];
#pragma unroll
    for (int di = 0; di < 4; ++di) { o[di][0] = (f32x4){0.f, 0.f, 0.f, 0.f}; o[di][1] = (f32x4){0.f, 0.f, 0.f, 0.f}; }
    float lrun[2] = {0.f, 0.f};
    float negmb;
    {
        float mq = fabsf(p.in[7][l * 64 + lane]), mk = fabsf(p.in[8][l * 64 + lane]);
#pragma unroll
        for (int o_ = 32; o_; o_ >>= 1) { mq = fmaxf(mq, __shfl_xor(mq, o_)); mk = fmaxf(mk, __shfl_xor(mk, o_)); }
        negmb = -(8.0f * 1.4426950408889634f * 1.03f) * mq * mk;
    }
    const bf16_t* kbase = KB + (size_t)(b * 2 + kvh) * NKEY * 64;
    const bf16_t* vbase = VT + (size_t)(b * 2 + kvh) * 64 * NKEY;
    const int c0 = tid, c1 = tid + 256;
    uint4 rkA0, rkA1, rvA0, rvA1, rkB0, rkB1, rvB0, rvB1;
#define ATT_LOAD(S, kt) do { \
        rk##S##0 = *(const uint4*)(kbase + (size_t)(kt) * 4096 + c0 * 8); rk##S##1 = *(const uint4*)(kbase + (size_t)(kt) * 4096 + c1 * 8); \
        rv##S##0 = *(const uint4*)(vbase + (size_t)(c0 >> 3) * NKEY + (kt) * 64 + (c0 & 7) * 8); \
        rv##S##1 = *(const uint4*)(vbase + (size_t)(c1 >> 3) * NKEY + (kt) * 64 + (c1 & 7) * 8); } while (0)
#define ATT_TILE(S, kt) do { __syncthreads(); \
        *(uint4*)(Ks + (c0 >> 3) * 72 + (c0 & 7) * 8) = rk##S##0; *(uint4*)(Ks + (c1 >> 3) * 72 + (c1 & 7) * 8) = rk##S##1; \
        *(uint4*)(Vs + (c0 >> 3) * 72 + (c0 & 7) * 8) = rv##S##0; *(uint4*)(Vs + (c1 >> 3) * 72 + (c1 & 7) * 8) = rv##S##1; \
        __syncthreads(); \
        if ((kt) + 2 < nkt) ATT_LOAD(S, (kt) + 2); \
        attn_tile_compute(Ks, Vs, qf, o, negmb, lrun, lr, g); } while (0)
    const int nkt = nkeys >> 6;
    ATT_LOAD(A, 0); ATT_LOAD(B, 1);
#pragma unroll 1
    for (int kt = 0; kt < nkt; kt += 2) { ATT_TILE(A, kt); ATT_TILE(B, kt + 1); }
#undef ATT_TILE
#undef ATT_LOAD
#pragma unroll
    for (int mi = 0; mi < 2; ++mi) {
        float lsum = lrun[mi]; lsum += __shfl_xor(lsum, 16); lsum += __shfl_xor(lsum, 32);
        const float inv = 1.0f / lsum;
#pragma unroll
        for (int di = 0; di < 4; ++di) {
            uint2 w; w.x = pack2(o[di][mi][0] * inv, o[di][mi][1] * inv); w.y = pack2(o[di][mi][2] * inv, o[di][mi][3] * inv);
            *(uint2*)(P + (size_t)(row0 + mi * 16 + lr) * NP + head * 64 + di * 16 + g * 4) = w;
        }
    }
    __syncthreads();
}

constexpr int RCH = 272;
template <int MODE>
__device__ __forceinline__ void rwkv_chunk_unit(const Params& p, int l, int u, unsigned char* lds) {
    const bf16_t* P = (const bf16_t*)(p.ws + OFF_P); bf16_t* YRW = (bf16_t*)(p.ws + OFF_YRW);
    float* RWE = (float*)(p.ws + OFF_RWE); const float* RWS0 = (const float*)(p.ws + OFF_RWS0);
    const int chain = u >> 3, cp = u & 7, b = chain >> 3, d = (chain >> 2) & 1, h = chain & 3;
    bf16_t* W2T = (bf16_t*)lds; bf16_t* A2T = W2T + 64 * 72;
    bf16_t* tw16 = A2T + 64 * 72; bf16_t* a116 = tw16 + 16 * 72;
    float* tw = (float*)(a116 + 16 * 72);
    float* a1s = tw + 1024; float* kks = a1s + 1024; float* rrs = kks + 1024; float* vvs = rrs + 1024;
    float* dec = vvs + 1024; float* kdr = dec + 1024; float* bbs = kdr + 1024;
    bf16_t* raw = (bf16_t*)dec;
    const int tid = tidx(), lane = tid & 63, wid = tid >> 6;
    const float* w2 = p.in[19] + (size_t)(l * 2 + d) * 64 * 256 + h * 64;
    const float* a2 = p.in[21] + (size_t)(l * 2 + d) * 64 * 256 + h * 64;
    __syncthreads();
    for (int i = tid; i < 2048; i += NTHR) {
        const int r2 = (i >> 6) * 2, j = i & 63;
        *(unsigned*)(W2T + j * 72 + r2) = pack2(w2[r2 * 256 + j], w2[(r2 + 1) * 256 + j]);
        *(unsigned*)(A2T + j * 72 + r2) = pack2(a2[r2 * 256 + j], a2[(r2 + 1) * 256 + j]);
    }
    const float* mu0 = p.in[17] + (size_t)l * 2 * 1152; const float* mu1 = mu0 + 1152;
    const float* w0 = p.in[18] + (l * 2 + d) * 256 + h * 64; const float* a0 = p.in[20] + (l * 2 + d) * 256 + h * 64;
    const float* k_k = p.in[23] + l * 256 + h * 64; const float* k_a = p.in[24] + l * 256 + h * 64;
    constexpr bool scan_wave = true;
    const int sel = wid >> 1;
    const bool isE = MODE == 0 && !(wid & 1);
    const int chunk = 2 * cp + sel;
    constexpr int NV = MODE == 0 ? 4 : 2;
    const int vb = MODE == 0 ? 0 : 2 * (wid & 1);
    const int vq = lane & 15, g = lane >> 4;
    const int lr = vq;
    f32x4 Zt[4][4];
#pragma unroll
    for (int kt = 0; kt < 4; ++kt)
#pragma unroll
        for (int vt = 0; vt < 4; ++vt)
#pragma unroll
            for (int j = 0; j < 4; ++j) Zt[kt][vt][j] = (isE && (16 * kt + 4 * g + j) == (16 * vt + lr)) ? 1.f : 0.f;
    bf16_t* ops = (bf16_t*)((unsigned char*)lds + 56320) + sel * 3968;
    bf16_t* Ar = ops; bf16_t* Br = ops + 576; bf16_t* Kr = ops + 1152; bf16_t* Rr = ops + 1728;
    bf16_t* NBt = ops + 2304; bf16_t* Kt = ops + 2816; bf16_t* Vt = ops + 3328;
    const float* gL = (const float*)(ops + 3840);
    float mum0[3], mum1[3];
#pragma unroll
    for (int i = 0; i < 3; ++i) {
        const int c = tid + i * NTHR, rem = c % 320, vec = rem >> 6, j = rem & 63;
        const int col = vec < 3 ? vec * 256 + h * 64 + j : (vec == 3 ? 768 : 896) + d * 64 + j;
        mum0[i] = c < 640 ? mu0[col] : 0.f; mum1[i] = c < 640 ? mu1[col] : 0.f;
    }
    uint4 pre0, pre1, pre2, pre3;
#define RW_ISSUE(I, SUB) do { const int q = tid + (I) * NTHR; pre##I = make_uint4(0u, 0u, 0u, 0u); \
        if (q < 800) { const int slot = q / 400, rem = q % 400, rr = rem / 40, seg = (rem % 40) >> 3, part = rem & 7; \
            int row, t, n; scan_pos(b, d, (2 * cp + slot) * RCH + (SUB) * 8, row, t, n); \
            const int tlo = d ? t - 7 : t, tt = tlo - 1 + rr; \
            const int col = (seg < 3 ? seg * 256 + h * 64 : (seg == 3 ? 768 : 896) + d * 64) + part * 8; \
            if (tt >= 0 && tt < n) pre##I = *(const uint4*)(P + (size_t)(row - t + tt) * NP + RWO + col); } } while (0)
#define RW_STORE(I) do { const int q = tid + (I) * NTHR; \
        if (q < 800) { const int slot = q / 400, rem = q % 400, rr = rem / 40, seg = (rem % 40) >> 3, part = rem & 7; \
            *(uint4*)(raw + (slot * 10 + rr) * 320 + seg * 64 + part * 8) = pre##I; } } while (0)
    RW_ISSUE(0, 0); RW_ISSUE(1, 0); RW_ISSUE(2, 0); RW_ISSUE(3, 0);
#pragma unroll 1
    for (int sub = 0; sub < RCH / 8; ++sub) {
        __syncthreads();
        RW_STORE(0); RW_STORE(1); RW_STORE(2); RW_STORE(3);
        if (sub + 1 < RCH / 8) { RW_ISSUE(0, sub + 1); RW_ISSUE(1, sub + 1); RW_ISSUE(2, sub + 1); RW_ISSUE(3, sub + 1); }
        __syncthreads();
        for (int c = tid; c < 640; c += NTHR) {
            const int slot = c >= 320 ? 1 : 0, rem = c - slot * 320, vec = rem >> 6, j = rem & 63;
            const int col = vec < 3 ? vec * 256 + h * 64 + j : (vec == 3 ? 768 : 896) + d * 64 + j;
            const float m0 = c < 256 ? mum0[0] : (c < 512 ? mum0[1] : mum0[2]), m1 = c < 256 ? mum1[0] : (c < 512 ? mum1[1] : mum1[2]);
            const bf16_t* pr = raw + slot * 3200 + rem;
            float* dstp = (vec == 0 ? rrs : vec == 1 ? kks : vvs) + slot * 512 + j;
            bf16_t* dst16 = (vec == 3 ? tw16 : a116) + slot * (8 * 72) + j;
            float prev = bf2f(pr[0]), cur = bf2f(pr[320]);
#pragma unroll
            for (int i = 0; i < 8; ++i) {
                const float nxt = bf2f(pr[(i + 2) * 320]);
                float sm = cur + (prev - cur) * m0 + (nxt - cur) * m1;
                if (vec == 3) sm = tanh_fast(sm);
                if (vec < 3) dstp[(d ? 7 - i : i) * 64] = sm; else dst16[(d ? 7 - i : i) * 72] = f2bf(sm);
                prev = cur; cur = nxt;
            }
        }
        __syncthreads();
        {
            const int lr_ = lane & 15, g_ = lane >> 4;
            f32x4 dw = {0.f, 0.f, 0.f, 0.f}, da = {0.f, 0.f, 0.f, 0.f};
#pragma unroll
            for (int ks = 0; ks < 2; ++ks) {
                const bf16x8 xt = *(const bf16x8*)(tw16 + lr_ * 72 + ks * 32 + g_ * 8), xa = *(const bf16x8*)(a116 + lr_ * 72 + ks * 32 + g_ * 8);
                const bf16x8 wb = *(const bf16x8*)(W2T + (wid * 16 + lr_) * 72 + ks * 32 + g_ * 8), ab = *(const bf16x8*)(A2T + (wid * 16 + lr_) * 72 + ks * 32 + g_ * 8);
                dw = __builtin_amdgcn_mfma_f32_16x16x32_bf16(xt, wb, dw, 0, 0, 0);
                da = __builtin_amdgcn_mfma_f32_16x16x32_bf16(xa, ab, da, 0, 0, 0);
            }
#pragma unroll
            for (int j = 0; j < 4; ++j) { tw[(4 * g_ + j) * 64 + wid * 16 + lr_] = dw[j]; a1s[(4 * g_ + j) * 64 + wid * 16 + lr_] = da[j]; }
        }
        __syncthreads();
        {
            const int ts = tid >> 4, j0 = (tid & 15) * 4;
            const f32x4 wv = *(const f32x4*)(w0 + j0) + *(const f32x4*)(tw + ts * 64 + j0), av = *(const f32x4*)(a0 + j0) + *(const f32x4*)(a1s + ts * 64 + j0);
            const f32x4 kraw = *(const f32x4*)(kks + ts * 64 + j0), kkw = *(const f32x4*)(k_k + j0), kaw = *(const f32x4*)(k_a + j0);
            f32x4 kkv = kraw * kkw;
            float ss = kkv[0] * kkv[0] + kkv[1] * kkv[1] + kkv[2] * kkv[2] + kkv[3] * kkv[3];
#pragma unroll
            for (int o = 8; o; o >>= 1) ss += __shfl_xor(ss, o);
            const float rn = rsqrtf(ss + 1e-12f);
            f32x4 dcv, kdv, bbv;
#pragma unroll
            for (int q = 0; q < 4; ++q) {
                dcv[q] = __expf(-0.6065306597126334f / (1.0f + __expf(-wv[q])));
                const float aa = sigmoidf_(av[q]);
                kdv[q] = kraw[q] * (1.f + (aa - 1.f) * kaw[q]);
                kkv[q] = kkv[q] * rn;
                bbv[q] = kkv[q] * aa;
            }
            *(f32x4*)(dec + ts * 64 + j0) = dcv; *(f32x4*)(kdr + ts * 64 + j0) = kdv; *(f32x4*)(kks + ts * 64 + j0) = kkv; *(f32x4*)(bbs + ts * 64 + j0) = bbv;
        }
        __syncthreads();
        {
            const int sl = tid >> 7, hf = (tid >> 6) & 1, k = tid & 63;
            bf16_t* ob = (bf16_t*)((unsigned char*)lds + 56320) + sl * 3968;
            if (hf == 0) {
                float gm = 1.f;
                union { uint4 q; bf16_t hh[8]; } nb, k8;
#pragma unroll
                for (int t = 0; t < 8; ++t) {
                    const int ts = sl * 8 + t;
                    const float gp = gm; gm *= dec[ts * 64 + k];
                    const float ig = 1.0f / gm;
                    const float be = bbs[ts * 64 + k] * ig, ka = kdr[ts * 64 + k] * ig;
                    ob[t * 72 + k] = f2bf(gp * kks[ts * 64 + k]); ob[576 + t * 72 + k] = f2bf(be); ob[1152 + t * 72 + k] = f2bf(ka); ob[1728 + t * 72 + k] = f2bf(gm * rrs[ts * 64 + k]);
                    nb.hh[t] = f2bf(-be); k8.hh[t] = f2bf(ka);
                }
                *(uint4*)(ob + 2304 + k * 8) = nb.q; *(uint4*)(ob + 2816 + k * 8) = k8.q;
                ((float*)(ob + 3840))[k] = gm;
            } else {
                union { uint4 q; bf16_t hh[8]; } v8;
#pragma unroll
                for (int t = 0; t < 8; ++t) v8.hh[t] = f2bf(vvs[(sl * 8 + t) * 64 + k]);
                *(uint4*)(ob + 3328 + k * 8) = v8.q;
            }
        }
        __syncthreads();
        {
#define RW_PK4(a) ({ union { s16x4 v; unsigned w[2]; } u_; u_.w[0] = pack2((a)[0], (a)[1]); u_.w[1] = pack2((a)[2], (a)[3]); u_.v; })
#define RW_MF16(A, B, C) __builtin_amdgcn_mfma_f32_16x16x16bf16_1k(A, B, C, 0, 0, 0)
#define RW_MF32(A, B, C) __builtin_amdgcn_mfma_f32_16x16x32_bf16(A, B, C, 0, 0, 0)
            const int lrc = lr & 7;
            const bool tv = lr < 8, gv2 = g < 2;
            const f32x4 z4 = {0.f, 0.f, 0.f, 0.f};
            f32x4 Nn = z4, NT = z4, MH1 = z4, G2 = z4, H2 = z4;
#pragma unroll
            for (int ks = 0; ks < 2; ++ks) {
                union { bf16x8 v; uint4 q; } fa, fb, fk, fr;
                fa.q = *(const uint4*)(Ar + lrc * 72 + ks * 32 + g * 8); fb.q = *(const uint4*)(Br + lrc * 72 + ks * 32 + g * 8);
                fr.q = *(const uint4*)(Rr + lrc * 72 + ks * 32 + g * 8);
                if (!tv) { fa.q = make_uint4(0u, 0u, 0u, 0u); fb.q = fa.q; fr.q = fa.q; }
                Nn = RW_MF32(fb.v, fa.v, Nn);
                NT = RW_MF32(fa.v, fb.v, NT);
                MH1 = RW_MF32(fb.v, fr.v, MH1);
                if (!isE) {
                    fk.q = *(const uint4*)(Kr + lrc * 72 + ks * 32 + g * 8);
                    if (!tv) fk.q = make_uint4(0u, 0u, 0u, 0u);
                    G2 = RW_MF32(fk.v, fa.v, G2);
                    H2 = RW_MF32(fk.v, fr.v, H2);
                }
            }
#pragma unroll
            for (int j = 0; j < 4; ++j) {
                const int i_ = 4 * g + j;
                Nn[j] = i_ < lr ? -Nn[j] : 0.f;
                NT[j] = lr < i_ ? -NT[j] : 0.f;
                MH1[j] = i_ <= lr ? -MH1[j] : 0.f;
                G2[j] = i_ < lr ? G2[j] : 0.f;
                H2[j] = i_ <= lr ? H2[j] : 0.f;
            }
            const s16x4 pN = RW_PK4(Nn), pNT = RW_PK4(NT);
            const f32x4 N2 = RW_MF16(pNT, pN, z4), N2T = RW_MF16(pN, pNT, z4);
            const s16x4 pN2 = RW_PK4(N2), pN2T = RW_PK4(N2T);
            const f32x4 N4 = RW_MF16(pN2T, pN2, z4);
            const s16x4 pN4 = RW_PK4(N4), pMH1 = RW_PK4(MH1), pG2 = RW_PK4(G2), pH2 = RW_PK4(H2);
            bf16x8 aP[2], rP[2];
#pragma unroll
            for (int m = 0; m < 2; ++m) {
                union { bf16x8 v; uint2 hq[2]; } ua, ur;
                ua.hq[0] = *(const uint2*)(Ar + lrc * 72 + 32 * m + 4 * g); ua.hq[1] = *(const uint2*)(Ar + lrc * 72 + 32 * m + 16 + 4 * g);
                ur.hq[0] = *(const uint2*)(Rr + lrc * 72 + 32 * m + 4 * g); ur.hq[1] = *(const uint2*)(Rr + lrc * 72 + 32 * m + 16 + 4 * g);
                if (!tv) { ua.hq[0] = make_uint2(0u, 0u); ua.hq[1] = ua.hq[0]; ur.hq[0] = ua.hq[0]; ur.hq[1] = ua.hq[0]; }
                aP[m] = ua.v; rP[m] = ur.v;
            }
            int orow[4];
#pragma unroll
            for (int j = 0; j < 4; ++j) { int t_, n_; scan_pos(b, d, chunk * RCH + sub * 8 + ((4 * g + j) & 7), orow[j], t_, n_); }
            f32x4 CT[4];
#pragma unroll
            for (int vt = 0; vt < 4; ++vt) {
                bf16x8 zb[2];
#pragma unroll
                for (int m = 0; m < 2; ++m) {
                    union { bf16x8 v; unsigned w[4]; } uz;
                    uz.w[0] = pack2(Zt[2 * m][vt][0], Zt[2 * m][vt][1]); uz.w[1] = pack2(Zt[2 * m][vt][2], Zt[2 * m][vt][3]);
                    uz.w[2] = pack2(Zt[2 * m + 1][vt][0], Zt[2 * m + 1][vt][1]); uz.w[3] = pack2(Zt[2 * m + 1][vt][2], Zt[2 * m + 1][vt][3]);
                    zb[m] = uz.v;
                }
                union { s16x4 v; uint2 q; } vf; vf.q = make_uint2(0u, 0u);
                if (!isE) { vf.q = *(const uint2*)(Vt + (16 * vt + lr) * 8 + 4 * (g & 1)); if (!gv2) vf.q = make_uint2(0u, 0u); }
                f32x4 c = RW_MF32(aP[0], zb[0], z4); c = RW_MF32(aP[1], zb[1], c);
                f32x4 y = RW_MF32(rP[0], zb[0], z4); y = RW_MF32(rP[1], zb[1], y);
                if (!isE) { c = RW_MF16(pG2, vf.v, c); y = RW_MF16(pH2, vf.v, y); }
                c = RW_MF16(pN, RW_PK4(c), c);
                c = RW_MF16(pN2, RW_PK4(c), c);
                c = RW_MF16(pN4, RW_PK4(c), c);
                y = RW_MF16(pMH1, RW_PK4(c), y);
                CT[vt] = c;
                if (gv2) {
                    bf16_t* ob = isE ? (bf16_t*)(p.ws + OFF_P) + 1024 + d * 256 + h * 64 + 16 * vt + lr : YRW + (size_t)d * T * 256 + h * 64 + 16 * vt + lr;
                    const size_t rs = isE ? (size_t)NP : (size_t)256;
#pragma unroll
                    for (int j = 0; j < 4; ++j) ob[(size_t)orow[j] * rs] = f2bf(y[j]);
                }
            }
#pragma unroll
            for (int kt = 0; kt < 4; ++kt) {
                union { s16x4 v; uint2 q; } nbf, ktf;
                nbf.q = *(const uint2*)(NBt + (16 * kt + lr) * 8 + 4 * (g & 1)); ktf.q = make_uint2(0u, 0u);
                if (!isE) ktf.q = *(const uint2*)(Kt + (16 * kt + lr) * 8 + 4 * (g & 1));
                if (!gv2) { nbf.q = make_uint2(0u, 0u); ktf.q = nbf.q; }
                const f32x4 gl = *(const f32x4*)(gL + 16 * kt + 4 * g);
#pragma unroll
                for (int vt = 0; vt < 4; ++vt) {
                    f32x4 z = RW_MF16(nbf.v, RW_PK4(CT[vt]), Zt[kt][vt]);
                    if (!isE) {
                        union { s16x4 v; uint2 q; } vf; vf.q = *(const uint2*)(Vt + (16 * vt + lr) * 8 + 4 * (g & 1)); if (!gv2) vf.q = make_uint2(0u, 0u);
                        z = RW_MF16(ktf.v, vf.v, z);
                    }
                    Zt[kt][vt] = z * gl;
                }
            }
#undef RW_PK4
#undef RW_MF16
#undef RW_MF32
        }
    }
    if (MODE == 0) {
        float* dst = RWE + ((size_t)(chain * 16 + chunk) * 2 + (isE ? 0 : 1)) * 4096;
#pragma unroll
        for (int vt = 0; vt < 4; ++vt)
#pragma unroll
            for (int kt = 0; kt < 4; ++kt) *(f32x4*)(dst + (16 * vt + lr) * 64 + 16 * kt + 4 * g) = Zt[kt][vt];
    }
    __syncthreads();
}

#undef RW_ISSUE
#undef RW_STORE
__device__ __forceinline__ void rwkv_passC_unit(const Params& p, int u, unsigned char* lds) {
    (void)lds;
    const bf16_t* P = (const bf16_t*)(p.ws + OFF_P); bf16_t* YRW = (bf16_t*)(p.ws + OFF_YRW); const float* RWS0 = (const float*)(p.ws + OFF_RWS0);
    const int chain = u >> 3, cp = u & 7, b = chain >> 3, d = (chain >> 2) & 1, h = chain & 3;
    const int tid = tidx(), lane = tid & 63, wid = tid >> 6, lr = lane & 15, g = lane >> 4;
#pragma unroll 1
    for (int cs = 0; cs < 2; ++cs) {
        const int chunk = 2 * cp + cs;
        const float* s0 = RWS0 + (size_t)(chain * 16 + chunk) * 4096;
        bf16x8 sb[4][2];
#pragma unroll
        for (int vt = 0; vt < 4; ++vt)
#pragma unroll
            for (int ks = 0; ks < 2; ++ks) {
                const float* sp = s0 + (vt * 16 + lr) * 64 + ks * 32 + g * 8;
                const f32x4 lo = *(const f32x4*)sp, hi = *(const f32x4*)(sp + 4);
                union { bf16x8 v; unsigned w[4]; } pk;
                pk.w[0] = pack2(lo[0], lo[1]); pk.w[1] = pack2(lo[2], lo[3]); pk.w[2] = pack2(hi[0], hi[1]); pk.w[3] = pack2(hi[2], hi[3]);
                sb[vt][ks] = pk.v;
            }
#pragma unroll 1
        for (int tile = wid; tile < RCH / 16; tile += 4) {
            const int pos0 = chunk * RCH + tile * 16;
            int rowA, tA, nA; scan_pos(b, d, pos0 + lr, rowA, tA, nA);
            const bf16_t* qp = P + (size_t)rowA * NP + 1024 + d * 256 + h * 64 + g * 8;
            const bf16x8 q0 = *(const bf16x8*)qp, q1 = *(const bf16x8*)(qp + 32);
            int rows[4];
#pragma unroll
            for (int j = 0; j < 4; ++j) { int t_, n_; scan_pos(b, d, pos0 + 4 * g + j, rows[j], t_, n_); }
#pragma unroll
            for (int vt = 0; vt < 4; ++vt) {
                f32x4 acc = {0.f, 0.f, 0.f, 0.f};
                acc = __builtin_amdgcn_mfma_f32_16x16x32_bf16(q0, sb[vt][0], acc, 0, 0, 0);
                acc = __builtin_amdgcn_mfma_f32_16x16x32_bf16(q1, sb[vt][1], acc, 0, 0, 0);
#pragma unroll
                for (int j = 0; j < 4; ++j) {
                    bf16_t* yp = YRW + ((size_t)d * T + rows[j]) * 256 + h * 64 + vt * 16 + lr;
                    *yp = f2bf(bf2f(*yp) + acc[j]);
                }
            }
        }
    }
}

__device__ __forceinline__ void rwkv_passB_unit(const Params& p, int chain, unsigned char* lds) {
    const float* RWE = (const float*)(p.ws + OFF_RWE); float* RWS0 = (float*)(p.ws + OFF_RWS0);
    float* Ss = (float*)lds;
    float* Es = Ss + 64 * 65; float* Ls = Es + 4096;
    const int tid = tidx(), v = tid >> 2, kq = tid & 3;
    __syncthreads();
    for (int i = tid; i < 64 * 65; i += NTHR) Ss[i] = 0.f;
#pragma unroll 1
    for (int c = 0; c < 16; ++c) {
        __syncthreads();
        for (int i = tid; i < 4096; i += NTHR) {
            RWS0[(size_t)(chain * 16 + c) * 4096 + i] = Ss[(i >> 6) * 65 + (i & 63)];
            Es[i] = RWE[((size_t)(chain * 16 + c) * 2) * 4096 + i];
            Ls[i] = RWE[((size_t)(chain * 16 + c) * 2 + 1) * 4096 + i];
        }
        __syncthreads();
        if (c == 15) break;
        f32x4 o[4];
#pragma unroll
        for (int i = 0; i < 4; ++i) o[i] = *(const f32x4*)(Ls + v * 64 + kq * 16 + i * 4);
#pragma unroll 4
        for (int k = 0; k < 64; ++k) {
            const float s = Ss[v * 65 + k];
#pragma unroll
            for (int i = 0; i < 4; ++i) o[i] += s * *(const f32x4*)(Es + k * 64 + kq * 16 + i * 4);
        }
        __syncthreads();
#pragma unroll
        for (int i = 0; i < 4; ++i)
#pragma unroll
            for (int q = 0; q < 4; ++q) Ss[v * 65 + kq * 16 + i * 4 + q] = o[i][q];
    }
    __syncthreads();
}

__device__ __forceinline__ float gelu_tanh(float x) { return 0.5f * x * (1.f + tanhf(0.7978845608028654f * (x + 0.044715f * x * x * x))); }
template <int MODE>
__device__ __forceinline__ void lru_chunk_unit(const Params& p, int l, int u, unsigned char* lds) {
    const bf16_t* P = (const bf16_t*)(p.ws + OFF_P);
    float* LRAB = (float*)(p.ws + OFF_LRAB); const float* LRH0 = (const float*)(p.ws + OFF_LRH0);
    const int chunk = u & 15, d = (u >> 4) & 1, nb = (u >> 5) & 3, b = u >> 7;
    bf16_t* HFd = (bf16_t*)(p.ws + (d ? OFF_HF1 : OFF_HF));
    bf16_t* rawx = (bf16_t*)lds;
    bf16_t* wT = rawx + 280 * 64;
    bf16_t* xcs = wT + 2 * 64 * 72;
    float* xcf = (float*)(xcs + 2 * 16 * 72);
    const int tid = tidx(), lane = tid & 63, wid = tid >> 6, lr = lane & 15, g = lane >> 4;
    const float* cw = p.in[28] + (size_t)l * 4 * 256 + nb * 64; const float* cb = p.in[29] + l * 256 + nb * 64;
    const float* wa = p.in[30] + ((size_t)(l * 2 + d) * 4 + nb) * 4096; const float* wx = p.in[32] + ((size_t)(l * 2 + d) * 4 + nb) * 4096;
    const float* ba = p.in[31] + (l * 2 + d) * 256 + nb * 64; const float* bx = p.in[33] + (l * 2 + d) * 256 + nb * 64; const float* lam = p.in[34] + (l * 2 + d) * 256 + nb * 64;
    const int na = chunk == 0 ? 256 : RCH;
    int rowA, tA, nA, rowB = 0, tB = 0, nB = 1;
    scan_pos(b, d, chunk * RCH, rowA, tA, nA);
    if (chunk == 0) scan_pos(b, d, 256, rowB, tB, nB);
    const int tloA = d ? tA - (na - 1) : tA, tloB = d ? tB - 15 : tB;
    const int nrA = na + 3;
    __syncthreads();
    for (int i = tid; i < 2048; i += NTHR) {
        const int cq = (i >> 6) * 2, ch = i & 63;
        *(unsigned*)(wT + ch * 72 + cq) = pack2(wa[cq * 64 + ch], wa[(cq + 1) * 64 + ch]);
        *(unsigned*)(wT + (64 + ch) * 72 + cq) = pack2(wx[cq * 64 + ch], wx[(cq + 1) * 64 + ch]);
    }
    {
        const int nrows = nrA + (chunk == 0 ? 19 : 0);
        for (int q = tid; q < nrows * 8; q += NTHR) {
            const int r = q >> 3, part = q & 7;
            const bool inB = r >= nrA;
            const int tt = inB ? tloB - 1 + (r - nrA) : tloA - 1 + r;
            const int nn = inB ? nB : nA;
            const int grow = inB ? rowB - tB + tt : rowA - tA + tt;
            uint4 v = make_uint4(0u, 0u, 0u, 0u);
            if (tt >= 0 && tt < nn) v = *(const uint4*)(P + (size_t)grow * NP + LRO + 256 + nb * 64 + part * 8);
            *(uint4*)(rawx + r * 64 + part * 8) = v;
        }
    }
    const int cc = tid & 63;
    const float cw0 = cw[cc], cw1 = cw[256 + cc], cw2 = cw[512 + cc], cw3 = cw[768 + cc], cbb = cb[cc];
    const int chq = wid * 16 + lr;
    const float baq = ba[chq], bxq = bx[chq], spq = -8.0f * softplusf_(-lam[chq]);
    float hst = 0.f, aprod = 1.f;
    if (MODE == 1) hst = __hip_atomic_load(LRH0 + (size_t)u * 64 + chq, __ATOMIC_RELAXED, __HIP_MEMORY_SCOPE_AGENT);
    __syncthreads();
#define LRU_CONV(sub) do { const int p0_ = (sub) * 16; const bool inB_ = p0_ >= na; const int q0_ = inB_ ? p0_ - na : p0_; \
        const int seglen_ = inB_ ? 16 : na, rbase_ = inB_ ? nrA : 0; \
        bf16_t* xs_ = xcs + ((sub) & 1) * (16 * 72); float* xf_ = xcf + ((sub) & 1) * 1024; \
        _Pragma("unroll") for (int i = 0; i < 4; ++i) { \
            const int tok = (tid >> 6) + 4 * i, qq = q0_ + tok, off = d ? seglen_ - 1 - qq : qq; \
            const bf16_t* rp = rawx + (rbase_ + off) * 64 + cc;                  \
            const float xv = cbb + cw0 * bf2f(rp[0]) + cw1 * bf2f(rp[64]) + cw2 * bf2f(rp[128]) + cw3 * bf2f(rp[192]); \
            xf_[tok * 64 + cc] = xv; xs_[tok * 72 + cc] = f2bf(xv); } } while (0)
    LRU_CONV(0);
    __syncthreads();
#pragma unroll 1
    for (int sub = 0; sub < RCH / 16; ++sub) {
        if (sub + 1 < RCH / 16) LRU_CONV(sub + 1);
        const bf16_t* xs = xcs + (sub & 1) * (16 * 72); const float* xf = xcf + (sub & 1) * 1024;
        f32x4 ra = {0.f, 0.f, 0.f, 0.f}, ia = {0.f, 0.f, 0.f, 0.f};
#pragma unroll
        for (int ks = 0; ks < 2; ++ks) {
            const bf16x8 xa = *(const bf16x8*)(xs + lr * 72 + ks * 32 + g * 8);
            const bf16x8 wfa = *(const bf16x8*)(wT + (wid * 16 + lr) * 72 + ks * 32 + g * 8);
            const bf16x8 wfx = *(const bf16x8*)(wT + (64 + wid * 16 + lr) * 72 + ks * 32 + g * 8);
            ra = __builtin_amdgcn_mfma_f32_16x16x32_bf16(xa, wfa, ra, 0, 0, 0);
            ia = __builtin_amdgcn_mfma_f32_16x16x32_bf16(xa, wfx, ia, 0, 0, 0);
        }
        float Al[4], Hl[4];
        {
            float A = 1.f, H = 0.f;
#pragma unroll
            for (int j = 0; j < 4; ++j) {
                const float r = sigmoidf_(ra[j] + baq), ig = sigmoidf_(ia[j] + bxq);
                const float log_a = r * spq;
                const float a = __expf(log_a);
                const float bb = sqrtf(-expm1f(2.0f * log_a)) * (ig * xf[(4 * g + j) * 64 + chq]);
                H = a * H + bb; A *= a; Al[j] = A; Hl[j] = H;
            }
        }
        float A = Al[3], H = Hl[3];
        {
            float Ap = __shfl(A, lane - 16), Hp = __shfl(H, lane - 16);
            if (g >= 1) { H = A * Hp + H; A = A * Ap; }
            Ap = __shfl(A, lane - 32); Hp = __shfl(H, lane - 32);
            if (g >= 2) { H = A * Hp + H; A = A * Ap; }
        }
        float Ae = __shfl(A, lane - 16), He = __shfl(H, lane - 16);
        if (g == 0) { Ae = 1.f; He = 0.f; }
        const float hs = He + Ae * hst;
        if (MODE == 1) {
            const int p0 = sub * 16;
            const bool inB = p0 >= na;
            const int q0 = inB ? p0 - na : p0, seglen = inB ? 16 : na;
#pragma unroll
            for (int j = 0; j < 4; ++j) {
                const int qq = q0 + 4 * g + j, off = d ? seglen - 1 - qq : qq;
                const int grow = inB ? rowB - tB + tloB + off : rowA - tA + tloA + off;
                HFd[(size_t)grow * 256 + nb * 64 + chq] = f2bf(Hl[j] + Al[j] * hs);
            }
        }
        const float At = __shfl(A, 48 + lr), Ht = __shfl(H, 48 + lr);
        hst = Ht + At * hst; aprod *= At;
        __syncthreads();
    }
#undef LRU_CONV
    if (MODE == 0 && g == 0) { LRAB[(size_t)u * 128 + chq] = aprod; LRAB[(size_t)u * 128 + 64 + chq] = hst; }
    __syncthreads();
}
__device__ __forceinline__ void lru_passB_unit(const Params& p, int uc) {
    const float* LRAB = (const float*)(p.ws + OFF_LRAB); float* LRH0 = (float*)(p.ws + OFF_LRH0);
    const int tid = tidx();
    if (tid < 64) {
        float hcar = 0.f;
        for (int c = 0; c < 16; ++c) {
            const size_t u = (size_t)uc * 16 + c;
            LRH0[u * 64 + tid] = hcar;
            hcar = __hip_atomic_load(LRAB + u * 128 + tid, __ATOMIC_RELAXED, __HIP_MEMORY_SCOPE_AGENT) * hcar + __hip_atomic_load(LRAB + u * 128 + 64 + tid, __ATOMIC_RELAXED, __HIP_MEMORY_SCOPE_AGENT);
        }
    }
}
__device__ __forceinline__ void phase_lru_combine(const Params& p, int l) {
    bf16_t* P = (bf16_t*)(p.ws + OFF_P); const bf16_t* HF0 = (const bf16_t*)(p.ws + OFF_HF); const bf16_t* HF1 = (const bf16_t*)(p.ws + OFF_HF1);
    const int nrows = l == 0 ? T : TX;
    for (int i = blockIdx.x * NTHR + tidx(); i < nrows * 32; i += gridDim.x * NTHR) {
        const int row = i >> 5, c = (i & 31) * 8;
        bf16_t* gp = P + (size_t)row * NP + LRO + c;
        union { uint4 q; bf16_t h[8]; } a, bq, gq, o;
        a.q = *(const uint4*)(HF0 + (size_t)row * 256 + c); bq.q = *(const uint4*)(HF1 + (size_t)row * 256 + c); gq.q = *(const uint4*)gp;
#pragma unroll
        for (int k = 0; k < 8; ++k) o.h[k] = f2bf((bf2f(a.h[k]) + bf2f(bq.h[k])) * gelu_tanh(bf2f(gq.h[k])));
        *(uint4*)gp = o.q;
    }
}

__device__ __forceinline__ bf16_t* zt_ptr(const Params& p, int var, int b, int col) {
    if (var) return (bf16_t*)(p.ws + OFF_HF) + ((size_t)b * 768 + col) * 256;
    if (col < 512) return (bf16_t*)(p.ws + OFF_ZTA) + ((size_t)b * 512 + col) * 4096;
    return (bf16_t*)(p.ws + OFF_RWOUT) + ((size_t)b * 256 + (col - 512)) * 4096;
}
__device__ __forceinline__ void phase_hyprep(const Params& p, int l, unsigned char* lds) {
    const bf16_t* P = (const bf16_t*)(p.ws + OFF_P);
    float* tile = (float*)lds;
    const float* cw = p.in[9] + (size_t)l * 3 * 768; const float* cb = p.in[10] + l * 768;
    const int tid = tidx(), cc = tid & 63, rq = tid >> 6;
    const int nux = 8 * 64 * 12, nuc = l == 0 ? 8 * 4 * 12 : 0;
    for (int u = blockIdx.x; u < nux + nuc; u += gridDim.x) {
        int var, b, tt, ct;
        if (u < nux) { var = 0; b = u / 768; const int r = u % 768; tt = r / 12; ct = r % 12; }
        else { const int k = u - nux; var = 1; b = k / 48; const int r = k % 48; tt = r / 12; ct = r % 12; }
        const int n = var ? CL : SEQ, rowb = var ? TX + b * CL : b * SEQ, t0 = tt * 64, col0 = ct * 64;
        __syncthreads();
        for (int q = tid; q < 66 * 8; q += NTHR) {
            const int r = q >> 3, c8 = (q & 7) * 8, t = t0 - 1 + r;
            union { uint4 v; bf16_t h[8]; } ld; ld.v = make_uint4(0u, 0u, 0u, 0u);
            if (t >= 0 && t < n) ld.v = *(const uint4*)(P + (size_t)(rowb + t) * NP + HYO + col0 + c8);
#pragma unroll
            for (int k = 0; k < 8; ++k) tile[r * 65 + c8 + k] = bf2f(ld.h[k]);
        }
        __syncthreads();
#pragma unroll 4
        for (int i = 0; i < 16; ++i) {
            const int cl = rq * 16 + i, col = col0 + cl;
            const float z = cb[col] + cw[col] * tile[cc * 65 + cl] + cw[768 + col] * tile[(cc + 1) * 65 + cl] + cw[1536 + col] * tile[(cc + 2) * 65 + cl];
            zt_ptr(p, var, b, col)[t0 + cc] = f2bf(z);
        }
    }
    __syncthreads();
}

template <bool DA, bool DB>
__device__ __forceinline__ void hy_dstep(f32x4 (&acc)[8][2], const bf16_t* rbase, const bf16_t* za, const bf16_t* zb, bool va, bool vb) {
#pragma unroll
    for (int ks = 0; ks < 4; ++ks) {
        union { uint4 q[2]; unsigned d[8]; } raw;
        raw.q[0] = *(const uint4*)(rbase + 32 * ks); raw.q[1] = *(const uint4*)(rbase + 32 * ks + 8);
        union { uint4 q; bf16x8 v; } fa, fb2;
        fa.q = make_uint4(0u, 0u, 0u, 0u); fb2.q = fa.q;
        if (DA) { fa.q = *(const uint4*)(za + 32 * ks); if (!va) fa.q = make_uint4(0u, 0u, 0u, 0u); }
        if (DB) { fb2.q = *(const uint4*)(zb + 32 * ks); if (!vb) fb2.q = make_uint4(0u, 0u, 0u, 0u); }
#pragma unroll
        for (int ph = 0; ph < 8; ++ph) {
            union { unsigned d[4]; bf16x8 v; } af;
            if ((ph & 1) == 0) {
#pragma unroll
                for (int k = 0; k < 4; ++k) af.d[k] = raw.d[4 - ph / 2 + k];
            } else {
                const int a0 = (7 - ph) / 2;
#pragma unroll
                for (int k = 0; k < 4; ++k) af.d[k] = __builtin_amdgcn_alignbit(raw.d[a0 + k + 1], raw.d[a0 + k], 16);
            }
            if (DA) acc[ph][0] = __builtin_amdgcn_mfma_f32_16x16x32_bf16(af.v, fa.v, acc[ph][0], 0, 0, 0);
            if (DB) acc[ph][1] = __builtin_amdgcn_mfma_f32_16x16x32_bf16(af.v, fb2.v, acc[ph][1], 0, 0, 0);
        }
    }
}
__device__ __forceinline__ void hyena_mfma_unit(const Params& p, int l, int u, unsigned char* lds) {
    bf16_t* P = (bf16_t*)(p.ws + OFF_P);
    const float* F = (const float*)(p.ws + OFF_FILT); const float* NORM = (const float*)(p.ws + OFF_NORM);
    const int bh = u >> 8, c = u & 255;
    bf16_t* Rb = (bf16_t*)lds;
    bf16_t* Zs = Rb + 8208;
    const int tid = tidx(), lane = tid & 63, wid = tid >> 6, lr = lane & 15, g = lane >> 4;
    const int bi = lr & 3, t1l = lr >> 2;
    __syncthreads();
    for (int q = tid; q < 2048; q += NTHR) {
        const int bq = q >> 9, tq = (q & 511) * 8;
        const uint4 v = *(const uint4*)(zt_ptr(p, 0, bh * 4 + bq, c) + tq);
        *(uint4*)(Zs + ((tq >> 7) * 4 + bq) * 136 + (tq & 127)) = v;
    }
#pragma unroll 1
    for (int o = 0; o < 2; ++o) {
        {
            const float inv = 1.0f / NORM[o * 256 + c];
            const float skip = p.in[16][(l * 2 + o) * 256 + c];
            const float* ff = F + (size_t)(o * 512 + c) * 4096; const float* fb = ff + (size_t)256 * 4096;
            for (int dl = tid; dl < 4096; dl += NTHR) {
                float vf = ff[dl] * inv; if (dl == 0) vf += skip;
                Rb[4096 - dl] = f2bf(vf);
                if (dl > 0) Rb[4096 + dl] = f2bf(fb[dl] * inv);
            }
            if (tid < 17) Rb[tid == 16 ? 0 : 8192 + tid] = 0;
        }
        __syncthreads();
        f32x4 acc[8][2];
#pragma unroll
        for (int ph = 0; ph < 8; ++ph) { acc[ph][0] = (f32x4){0.f, 0.f, 0.f, 0.f}; acc[ph][1] = (f32x4){0.f, 0.f, 0.f, 0.f}; }
#pragma unroll 1
        for (int d1 = -31; d1 <= 31; ++d1) {
            const int s1a = 8 * wid - d1, s1b = s1a + 4;
            const bool ta = (s1a + 3 >= 0) && (s1a <= 31), tb = (s1b + 3 >= 0) && (s1b <= 31);
            if (!ta && !tb) continue;
            const int sa = s1a + t1l, sb = s1b + t1l;
            const bool va = (unsigned)sa < 32u, vb = (unsigned)sb < 32u;
            const bf16_t* za = Zs + ((va ? sa : 0) * 4 + bi) * 136 + g * 8;
            const bf16_t* zb = Zs + ((vb ? sb : 0) * 4 + bi) * 136 + g * 8;
            const bf16_t* rbase = Rb + 4096 + g * 8 - 8 * lr - 128 * d1 - 8;
            if (ta && tb) hy_dstep<true, true>(acc, rbase, za, zb, va, vb);
            else if (ta) hy_dstep<true, false>(acc, rbase, za, zb, va, vb);
            else hy_dstep<false, true>(acc, rbase, za, zb, va, vb);
        }
        __syncthreads();
        if (o == 0) {
#pragma unroll
            for (int ni = 0; ni < 2; ++ni) {
                const int t1 = 8 * wid + 4 * ni + t1l, b = bh * 4 + bi;
                const bf16_t* gate = zt_ptr(p, 0, b, 256 + c) + t1 * 128 + 32 * g;
                bf16_t* zo = Zs + (t1 * 4 + bi) * 136 + 32 * g;
#pragma unroll
                for (int ph = 0; ph < 8; ++ph)
#pragma unroll
                    for (int j = 0; j < 4; ++j) zo[ph + 8 * j] = f2bf(bf2f(gate[ph + 8 * j]) * acc[ph][ni][j]);
            }
        } else {
#pragma unroll
            for (int ni = 0; ni < 2; ++ni) {
                const int t1 = 8 * wid + 4 * ni + t1l, b = bh * 4 + bi;
                const bf16_t* gate = zt_ptr(p, 0, b, 512 + c) + t1 * 128 + 32 * g;
                const int prow = b * SEQ + t1 * 128 + 32 * g;
#pragma unroll
                for (int ph = 0; ph < 8; ++ph) {
                    int phv = ph; asm volatile("" : "+v"(phv));
#pragma unroll
                    for (int j = 0; j < 4; ++j) P[(size_t)(prow + phv + 8 * j) * NP + HYO + c] = f2bf(bf2f(gate[ph + 8 * j]) * acc[ph][ni][j]);
                }
            }
        }
        __syncthreads();
    }
}

__device__ __forceinline__ void hyena_ctx_unit(const Params& p, int l, int c, unsigned char* lds) {
    bf16_t* P = (bf16_t*)(p.ws + OFF_P);
    const float* FC = (const float*)(p.ws + OFF_FILT) + (size_t)4096 * 1024; const float* NORM = (const float*)(p.ws + OFF_NORM);
    float* Hc = (float*)lds;
    float* zin = Hc + 512;
    const int t = tidx();
    __syncthreads();
#pragma unroll
    for (int b = 0; b < 8; ++b) zin[b * 256 + t] = bf2f(zt_ptr(p, 1, b, c)[t]);
#pragma unroll 1
    for (int o = 0; o < 2; ++o) {
        const float inv = 1.0f / NORM[(2 + o) * 256 + c];
        const float* ff = FC + (size_t)(o * 512 + c) * 256; const float* fb = ff + (size_t)256 * 256;
        float vf = ff[t] * inv; if (t == 0) vf += p.in[16][(l * 2 + o) * 256 + c];
        Hc[255 + t] = vf;
        if (t > 0) Hc[255 - t] = fb[t] * inv;
        if (t == 0) Hc[511] = 0.f;
        __syncthreads();
        float y[8];
#pragma unroll
        for (int b = 0; b < 8; ++b) y[b] = 0.f;
        for (int s = 0; s < 256; ++s) {
            const float hv = Hc[t - s + 255];
#pragma unroll
            for (int b = 0; b < 8; ++b) y[b] += hv * zin[b * 256 + s];
        }
        __syncthreads();
#pragma unroll
        for (int b = 0; b < 8; ++b) {
            const float gt = bf2f(zt_ptr(p, 1, b, (o == 0 ? 256 : 512) + c)[t]);
            if (o == 0) zin[b * 256 + t] = gt * y[b];
            else P[(size_t)(TX + b * CL + t) * NP + HYO + c] = f2bf(gt * y[b]);
        }
        __syncthreads();
    }
}

__device__ __forceinline__ void rwkv_readout_unit(const Params& p, int l, int u, unsigned char* lds) {
    const bf16_t* P = (const bf16_t*)(p.ws + OFF_P); const bf16_t* YRW = (const bf16_t*)(p.ws + OFF_YRW); bf16_t* RWOUT = (bf16_t*)(p.ws + OFF_RWOUT);
    float* sm = (float*)lds;
    const int tid = tidx(), row0 = u * 8;
    const bool isx = row0 < TX;
    const int n = isx ? SEQ : CL;
    const float* mu0 = p.in[17] + (size_t)l * 2 * 1152; const float* mu1 = mu0 + 1152;
    __syncthreads();
    bf16_t* raw = (bf16_t*)(sm + 8 * 1152);
    float* dbuf = (float*)raw;
    bf16_t* xa = (bf16_t*)(lds + 61440);
    bf16_t* xg = xa + 2 * 16 * 72;
    {
        const int tb = isx ? (row0 & 4095) : ((row0 - TX) & 255);
        for (int q = tid; q < 10 * 144; q += NTHR) {
            const int rr = q / 144, part = q % 144, tt = tb - 1 + rr;
            uint4 v = make_uint4(0u, 0u, 0u, 0u);
            if (tt >= 0 && tt < n) v = *(const uint4*)(P + (size_t)(row0 - 1 + rr) * NP + RWO + part * 8);
            *(uint4*)(raw + rr * 1152 + part * 8) = v;
        }
    }
    __syncthreads();
    for (int idx = tid; idx < 8 * 1152; idx += NTHR) {
        const int tok = idx / 1152, col = idx % 1152;
        const bf16_t* pr = raw + (tok + 1) * 1152 + col;
        const float cur = bf2f(pr[0]), prev = bf2f(pr[-1152]), nxt = bf2f(pr[1152]);
        float v = cur + (prev - cur) * mu0[col] + (nxt - cur) * mu1[col];
        if (col < 896) sm[idx] = v;
        else if (col < 1024) xa[((col - 896) >> 6) * (16 * 72) + tok * 72 + ((col - 896) & 63)] = f2bf(v);
        else xg[tok * 136 + (col - 1024)] = f2bf(sigmoidf_(v));
    }
    __syncthreads();
    {
        const int lane = tid & 63, wid = tid >> 6, lr = lane & 15, g = lane >> 4;
        const bf16_t* A2T = (const bf16_t*)(p.ws + OFF_RWL); const bf16_t* G2T = A2T + 2 * 256 * 64;
#pragma unroll 1
        for (int nt = 0; nt < 4; ++nt) {
            const int cq = 64 * wid + 16 * nt + lr;
            f32x4 d0 = {0.f, 0.f, 0.f, 0.f}, d1 = {0.f, 0.f, 0.f, 0.f}, dg = {0.f, 0.f, 0.f, 0.f};
#pragma unroll
            for (int ks = 0; ks < 2; ++ks) {
                const bf16x8 x0 = *(const bf16x8*)(xa + lr * 72 + ks * 32 + g * 8), x1 = *(const bf16x8*)(xa + 16 * 72 + lr * 72 + ks * 32 + g * 8);
                const bf16x8 b0 = *(const bf16x8*)(A2T + (size_t)cq * 64 + ks * 32 + g * 8), b1 = *(const bf16x8*)(A2T + 256 * 64 + (size_t)cq * 64 + ks * 32 + g * 8);
                d0 = __builtin_amdgcn_mfma_f32_16x16x32_bf16(x0, b0, d0, 0, 0, 0);
                d1 = __builtin_amdgcn_mfma_f32_16x16x32_bf16(x1, b1, d1, 0, 0, 0);
            }
#pragma unroll
            for (int ks = 0; ks < 4; ++ks) {
                const bf16x8 xv = *(const bf16x8*)(xg + lr * 136 + ks * 32 + g * 8);
                const bf16x8 bg = *(const bf16x8*)(G2T + (size_t)cq * 128 + ks * 32 + g * 8);
                dg = __builtin_amdgcn_mfma_f32_16x16x32_bf16(xv, bg, dg, 0, 0, 0);
            }
            if (g < 2) {
#pragma unroll
                for (int j = 0; j < 4; ++j) { const int tk = 4 * g + j; dbuf[tk * 256 + cq] = d0[j]; dbuf[(8 + tk) * 256 + cq] = d1[j]; dbuf[(16 + tk) * 256 + cq] = dg[j]; }
            }
        }
    }
    __syncthreads();
    const int c = tid;
    float av0[8], av1[8], gv[8];
    const float a00 = p.in[20][(l * 2 + 0) * 256 + c], a01 = p.in[20][(l * 2 + 1) * 256 + c];
#pragma unroll
    for (int k = 0; k < 8; ++k) { av0[k] = a00 + dbuf[k * 256 + c]; av1[k] = a01 + dbuf[(8 + k) * 256 + c]; gv[k] = dbuf[(16 + k) * 256 + c]; }
    const float ka = p.in[24][l * 256 + c], rk = p.in[25][l * 256 + c], lw = p.in[26][l * 256 + c], lb = p.in[27][l * 256 + c];
#pragma unroll
    for (int k = 0; k < 8; ++k) {
        const int row = row0 + k;
        const float s0 = sigmoidf_(av0[k]), s1 = sigmoidf_(av1[k]);
        const float kv = sm[k * 1152 + 256 + c], rr = sm[k * 1152 + c], vv = sm[k * 1152 + 512 + c];
        const float kd = kv * (1.f + (s0 - 1.f) * ka) + kv * (1.f + (s1 - 1.f) * ka);
        const float cs = wave_sum(rr * kd * rk);
        const float yv = bf2f(YRW[(size_t)row * 256 + c]) + bf2f(YRW[((size_t)T + row) * 256 + c]);
        const float mean = wave_sum(yv) * (1.0f / 64.0f);
        const float dv = yv - mean;
        const float var = wave_sum(dv * dv) * (1.0f / 64.0f);
        const float yn = dv * rsqrtf(var + 64e-5f) * lw + lb;
        RWOUT[(size_t)row * 256 + c] = f2bf((yn + cs * vv) * gv[k]);
    }
    __syncthreads();
}

struct PhMerge {
    bf16_t* P; const bf16_t* HX; const bf16_t* WIN; const bf16_t* WBR; const bf16_t* RWOUT; int wr, wc, lr, g;
    unsigned gsp[4][4][2], mac[4][4][2];
    static constexpr int nseg = 8;
    __device__ __forceinline__ bool valid(int, int) const { return true; }
    __device__ __forceinline__ int nk(int s) const { return (s & 1) ? (s == 1 ? 8 : 4) : 16; }
    __device__ __forceinline__ const bf16_t* arow(int mt, int, int s, int r) const {
        const int m = mt * 128 + r;
        if (!(s & 1)) return HX + (size_t)m * 1024;
        if (s == 1) return P + (size_t)m * NP + QO;
        if (s == 3) return P + (size_t)m * NP + HYO;
        if (s == 5) return RWOUT + (size_t)m * 256;
        return P + (size_t)m * NP + LRO;
    }
    __device__ __forceinline__ const bf16_t* brow(int, int nt, int s, int r) const {
        const int n = nt * 128 + r;
        if (!(s & 1)) return WIN + (size_t)(GTO + (s >> 1) * 1024 + n) * 1024;
        return WBR + (size_t)n * 1280 + (s == 1 ? 0 : (s == 3 ? 512 : (s == 5 ? 768 : 1024)));
    }
    __device__ __forceinline__ void seg_end(int mt, int nt, int s, f32x4 (&acc)[4][4]) {
        if (!(s & 1)) {
#pragma unroll
            for (int ni = 0; ni < 4; ++ni)
#pragma unroll
                for (int mi = 0; mi < 4; ++mi) {
                    float sg[4];
#pragma unroll
                    for (int j = 0; j < 4; ++j) sg[j] = 1.0f / (1.0f + __expf(-acc[ni][mi][j]));
                    gsp[ni][mi][0] = pack2(sg[0], sg[1]); gsp[ni][mi][1] = pack2(sg[2], sg[3]);
                    acc[ni][mi] = (f32x4){0.f, 0.f, 0.f, 0.f};
                }
        } else {
#pragma unroll
            for (int ni = 0; ni < 4; ++ni)
#pragma unroll
                for (int mi = 0; mi < 4; ++mi) {
                    const unsigned g0 = gsp[ni][mi][0], g1 = gsp[ni][mi][1];
                    const f32x4 gs = {__uint_as_float(g0 << 16), __uint_as_float(g0 & 0xffff0000u), __uint_as_float(g1 << 16), __uint_as_float(g1 & 0xffff0000u)};
                    const unsigned m0 = mac[ni][mi][0], m1 = mac[ni][mi][1];
                    const f32x4 ms = {__uint_as_float(m0 << 16), __uint_as_float(m0 & 0xffff0000u), __uint_as_float(m1 << 16), __uint_as_float(m1 & 0xffff0000u)};
                    const f32x4 r = ms + gs * acc[ni][mi];
                    mac[ni][mi][0] = pack2(r[0], r[1]); mac[ni][mi][1] = pack2(r[2], r[3]);
                    acc[ni][mi] = (f32x4){0.f, 0.f, 0.f, 0.f};
                }
            if (s == 7) {
                const int t_ = tidx(), lr_ = t_ & 15, g_ = (t_ >> 4) & 3, wc_ = (t_ >> 6) & 1, wr_ = t_ >> 7;
#pragma unroll
                for (int ni = 0; ni < 4; ++ni)
#pragma unroll
                    for (int mi = 0; mi < 4; ++mi) {
                        const int m = mt * 128 + wr_ * 64 + mi * 16 + lr_, n = nt * 128 + wc_ * 64 + ni * 16 + g_ * 4;
                        uint2 o; o.x = mac[ni][mi][0]; o.y = mac[ni][mi][1];
                        *(uint2*)(P + (size_t)m * NP + RWO + n) = o;
                        mac[ni][mi][0] = 0u; mac[ni][mi][1] = 0u;
                    }
            }
        }
    }
};
__device__ __forceinline__ void phase_merge(const Params& p, int l, unsigned char* lds) {
    const int lane = tidx() & 63, wid = tidx() >> 6;
    PhMerge ph;
    ph.P = (bf16_t*)(p.ws + OFF_P); ph.HX = (const bf16_t*)(p.ws + OFF_HX); ph.WIN = (const bf16_t*)(p.ws + OFF_WIN);
    ph.WBR = (const bf16_t*)(p.ws + OFF_WBR); ph.RWOUT = (const bf16_t*)(p.ws + OFF_RWOUT);
    ph.wr = wid >> 1; ph.wc = wid & 1; ph.lr = lane & 15; ph.g = lane >> 4;
#pragma unroll
    for (int ni = 0; ni < 4; ++ni)
#pragma unroll
        for (int mi = 0; mi < 4; ++mi) { ph.mac[ni][mi][0] = 0u; ph.mac[ni][mi][1] = 0u; ph.gsp[ni][mi][0] = 0u; ph.gsp[ni][mi][1] = 0u; }
    const TileSched ts_(l == 0 ? 272 : 256, 8);
    gemm_stream<4>(ph, ts_, lds);
}

struct PhWout {
    const Params* pp; const bf16_t* P; const bf16_t* WOUT; const float* MOD; int l; int wr, wc, lr, g;
    static constexpr int nseg = 1;
    __device__ __forceinline__ bool valid(int, int) const { return true; }
    __device__ __forceinline__ int nk(int) const { return 16; }
    __device__ __forceinline__ const bf16_t* arow(int mt, int, int, int r) const { return P + (size_t)(mt * 128 + r) * NP + RWO; }
    __device__ __forceinline__ const bf16_t* brow(int, int nt, int, int r) const { return WOUT + (size_t)(nt * 128 + r) * 1024; }
    __device__ __forceinline__ void seg_end(int mt, int nt, int, f32x4 (&acc)[4][4]) const {
#pragma unroll
        for (int mi = 0; mi < 4; ++mi) {
            const int m = mt * 128 + wr * 64 + mi * 16 + lr;
            const float* src = stream_in_row(*pp, l, m); float* dst = stream_out_row(*pp, m);
            const float* g1 = MOD + (size_t)(l * 9 + mod_row(m)) * 6144 + 2048;
#pragma unroll
            for (int ni = 0; ni < 4; ++ni) {
                const int n = nt * 128 + wc * 64 + ni * 16 + g * 4;
                const f32x4 xin = *(const f32x4*)(src + n), gg = *(const f32x4*)(g1 + n);
                *(f32x4*)(dst + n) = xin + gg * acc[ni][mi];
                acc[ni][mi] = (f32x4){0.f, 0.f, 0.f, 0.f};
            }
        }
    }
};
__device__ __forceinline__ void phase_wout(const Params& p, int l, unsigned char* lds) {
    const int lane = tidx() & 63, wid = tidx() >> 6;
    PhWout ph{&p, (const bf16_t*)(p.ws + OFF_P), (const bf16_t*)(p.ws + OFF_WOUT), (const float*)(p.ws + OFF_MOD), l, wid >> 1, wid & 1, lane & 15, lane >> 4};
    const TileSched ts_(l == 0 ? 272 : 256, 8);
    gemm_stream<4>(ph, ts_, lds);
}

__device__ __forceinline__ void phase_route(const Params& p, int l, unsigned char* lds) {
    const int lane = tidx() & 63, gw = blockIdx.x * 4 + (tidx() >> 6), nw = gridDim.x * 4;
    bf16_t* HX = (bf16_t*)(p.ws + OFF_HX);
    const float* MOD = (const float*)(p.ws + OFF_MOD);
    int* CNT = (int*)(p.ws + OFF_CNT); int* RTE = (int*)(p.ws + OFF_RTE); float2* RTW = (float2*)(p.ws + OFF_RTW); int* ROWTOK = (int*)(p.ws + OFF_ROWTOK);
    for (int i = blockIdx.x * NTHR + tidx(); i < MAXROWS; i += gridDim.x * NTHR) ROWTOK[i] = -1;
    int* hist = (int*)lds;
    float* wgs = (float*)(lds + 256);
    const float* wg = p.in[40] + (size_t)l * 1024 * 4; const float* wrt = p.in[42] + (size_t)l * 1024 * 16;
    __syncthreads();
    if (tidx() < 16) hist[tidx()] = 0;
    for (int i = tidx(); i < 1024; i += NTHR) *(f32x4*)(wgs + i * 4) = *(const f32x4*)(wg + i * 4);
    __syncthreads();
    const int nrows = l == 0 ? T : TX;
    for (int row = gw; row < nrows; row += nw) {
        const float* src = stream_out_row(p, row);
        f32x4 v[4]; float ss = 0.f;
#pragma unroll
        for (int i = 0; i < 4; ++i) { v[i] = *(const f32x4*)(src + i * 256 + lane * 4); ss += v[i][0] * v[i][0] + v[i][1] * v[i][1] + v[i][2] * v[i][2] + v[i][3] * v[i][3]; }
        ss = wave_sum(ss);
        const float rstd = rsqrtf(ss * (1.0f / 1024.0f) + 1e-6f);
        const float* mod = MOD + (size_t)(l * 9 + mod_row(row)) * 6144;
        float lg[4] = {0.f, 0.f, 0.f, 0.f}, hv[4][4];
#pragma unroll
        for (int i = 0; i < 4; ++i) {
            const int k = i * 256 + lane * 4;
            const f32x4 sh = *(const f32x4*)(mod + 3072 + k), sc = *(const f32x4*)(mod + 4096 + k);
#pragma unroll
            for (int j = 0; j < 4; ++j) hv[i][j] = v[i][j] * rstd * (1.f + sc[j]) + sh[j];
            uint2 o; o.x = pack2(hv[i][0], hv[i][1]); o.y = pack2(hv[i][2], hv[i][3]);
            *(uint2*)(HX + (size_t)row * 1024 + k) = o;
#pragma unroll
            for (int j = 0; j < 4; ++j) {
                const f32x4 w4 = *(const f32x4*)(wgs + (k + j) * 4);
                lg[0] += hv[i][j] * w4[0]; lg[1] += hv[i][j] * w4[1]; lg[2] += hv[i][j] * w4[2]; lg[3] += hv[i][j] * w4[3];
            }
        }
#pragma unroll
        for (int c = 0; c < 4; ++c) lg[c] = wave_sum(lg[c]) + p.in[41][l * 4 + c];
        int gi = 0; float gm = lg[0];
#pragma unroll
        for (int c = 1; c < 4; ++c) if (lg[c] > gm) { gm = lg[c]; gi = c; }
        gi = __builtin_amdgcn_readfirstlane(gi);
        float el[4] = {0.f, 0.f, 0.f, 0.f};
#pragma unroll
        for (int i = 0; i < 4; ++i)
#pragma unroll
            for (int j = 0; j < 4; ++j) {
                const f32x4 r4 = *(const f32x4*)(wrt + (size_t)(i * 256 + lane * 4 + j) * 16 + gi * 4);
                el[0] += hv[i][j] * r4[0]; el[1] += hv[i][j] * r4[1]; el[2] += hv[i][j] * r4[2]; el[3] += hv[i][j] * r4[3];
            }
#pragma unroll
        for (int c = 0; c < 4; ++c) el[c] = wave_sum(el[c]) + p.in[43][l * 16 + gi * 4 + c];
        if (lane == 0) {
            float gs = 0.f;
#pragma unroll
            for (int c = 0; c < 4; ++c) gs += expf(lg[c] - gm);
            const float gval = 1.0f / gs;
            int ia = 0; float ma = el[0];
#pragma unroll
            for (int c = 1; c < 4; ++c) if (el[c] > ma) { ma = el[c]; ia = c; }
            int ib = -1; float mb = -3.0e38f;
#pragma unroll
            for (int c = 0; c < 4; ++c) if (c != ia && el[c] > mb) { mb = el[c]; ib = c; }
            const float eb = expf(mb - ma);
            const float wa = gval / (1.0f + eb), wb = gval * eb / (1.0f + eb);
            const int ea = gi * 4 + ia, ebi = gi * 4 + ib;
            RTE[row] = ea | (ebi << 8);
            RTW[row] = make_float2(wa, wb);
            atomicAdd(&hist[ea], 1); atomicAdd(&hist[ebi], 1);
        }
    }
    __syncthreads();
    if (tidx() < 16) ((int*)(p.ws + OFF_WGH))[blockIdx.x * 16 + tidx()] = hist[tidx()];
    __syncthreads();
}

__device__ __forceinline__ void moe_offsets(const Params& p, int* off  ) {
    const int* CNT = (const int*)(p.ws + OFF_CNT);
    __syncthreads();
    if (tidx() == 0) { int a = 0; for (int e = 0; e < 16; ++e) { off[e] = a; a += (__hip_atomic_load(CNT + e, __ATOMIC_RELAXED, __HIP_MEMORY_SCOPE_AGENT) + 127) & ~127; } off[16] = a; }
    __syncthreads();
}

__device__ __forceinline__ void phase_lists(const Params& p, int l, unsigned char* lds) {
    int* off = (int*)lds;
    int* tot = off + 32;
    int* base = off + 64;
    int* cur = off + 96;
    int* pa = off + 128; int* pp = pa + 256;
    int* CNT = (int*)(p.ws + OFF_CNT); const int* RTE = (const int*)(p.ws + OFF_RTE); int* TOKPOS = (int*)(p.ws + OFF_TOKPOS); int* ROWTOK = (int*)(p.ws + OFF_ROWTOK);
    const int* WGH = (const int*)(p.ws + OFF_WGH);
    const int nrows = l == 0 ? T : TX, tid = tidx(), lane = tid & 63, G_ = (int)gridDim.x, me = (int)blockIdx.x;
    __syncthreads();
    {
        const int e = tid & 15, pt = tid >> 4;
        int sa = 0, sp = 0;
        for (int w = pt; w < G_; w += 16) { const int hv = __hip_atomic_load(WGH + w * 16 + e, __ATOMIC_RELAXED, __HIP_MEMORY_SCOPE_AGENT); sa += hv; if (w < me) sp += hv; }
        pa[pt * 16 + e] = sa; pp[pt * 16 + e] = sp;
    }
    __syncthreads();
    if (tid < 16) {
        int ta = 0, tp = 0;
        for (int q = 0; q < 16; ++q) { ta += pa[q * 16 + tid]; tp += pp[q * 16 + tid]; }
        tot[tid] = ta; base[tid] = tp; cur[tid] = 0;
        if (me == 0) CNT[tid] = ta;
    }
    __syncthreads();
    if (tid == 0) { int a = 0; for (int e = 0; e < 16; ++e) { off[e] = a; a += (tot[e] + 127) & ~127; } off[16] = a; }
    __syncthreads();
    const int gw = me * 4 + (tid >> 6), nw = G_ * 4;
    for (int row = gw; row < nrows; row += nw) {
        if (lane == 0) {
            const int rte = RTE[row], e0 = rte & 255, e1 = (rte >> 8) & 255;
            const int p0 = off[e0] + base[e0] + atomicAdd(&cur[e0], 1);
            const int p1 = off[e1] + base[e1] + atomicAdd(&cur[e1], 1);
            ROWTOK[p0] = row; ROWTOK[p1] = row; TOKPOS[row * 2] = p0; TOKPOS[row * 2 + 1] = p1;
        }
    }
    __syncthreads();
}

__device__ __forceinline__ int moe_expert(const int* off, int rt) {
    int e = 0;
#pragma unroll
    for (int q = 1; q < 16; ++q) if (rt * 128 >= off[q]) e = q;
    return e;
}
struct PhUp {
    const bf16_t* HX; const bf16_t* W13; bf16_t* H; const int* ROWTOK; const int* off; int wr, wc, lr, g;
    static constexpr int nseg = 1;
    __device__ __forceinline__ bool valid(int, int) const { return true; }
    __device__ __forceinline__ int nk(int) const { return 16; }
    __device__ __forceinline__ const bf16_t* arow(int rt, int, int, int r) const { const int t = ROWTOK[rt * 128 + r]; return HX + (size_t)(t < 0 ? 0 : t) * 1024; }
    __device__ __forceinline__ const bf16_t* brow(int rt, int nt, int, int r) const { return W13 + ((size_t)moe_expert(off, rt) * 1024 + nt * 128 + r) * 1024; }
    __device__ __forceinline__ void seg_end(int rt, int nt, int, f32x4 (&acc)[4][4]) const {
#pragma unroll
        for (int np = 0; np < 2; ++np)
#pragma unroll
            for (int mi = 0; mi < 4; ++mi) {
                const int m = rt * 128 + wr * 64 + mi * 16 + lr;
                const int hc = (nt * 128 + wc * 64 + np * 32) / 2 + g * 4;
                float hv[4];
#pragma unroll
                for (int j = 0; j < 4; ++j) { const float a = acc[2 * np][mi][j], bq = acc[2 * np + 1][mi][j]; hv[j] = a / (1.0f + __expf(-a)) * bq; }
                uint2 o; o.x = pack2(hv[0], hv[1]); o.y = pack2(hv[2], hv[3]);
                *(uint2*)(H + (size_t)m * 512 + hc) = o;
                acc[2 * np][mi] = (f32x4){0.f, 0.f, 0.f, 0.f}; acc[2 * np + 1][mi] = (f32x4){0.f, 0.f, 0.f, 0.f};
            }
    }
};
__device__ __forceinline__ void phase_moe_up(const Params& p, unsigned char* lds) {
    int* off = (int*)(lds + LDS_BYTES - 256);
    moe_offsets(p, off);
    const int lane = tidx() & 63, wid = tidx() >> 6;
    PhUp ph{(const bf16_t*)(p.ws + OFF_HX), (const bf16_t*)(p.ws + OFF_W13), (bf16_t*)(p.ws + OFF_H), (const int*)(p.ws + OFF_ROWTOK), off, wid >> 1, wid & 1, lane & 15, lane >> 4};
    const TileSched ts_(off[16] >> 7, 8);
    gemm_stream<4>(ph, ts_, lds);
}

struct PhDown {
    const bf16_t* H; const bf16_t* W2; bf16_t* Y2; const int* off; int wr, wc, lr, g;
    static constexpr int nseg = 1;
    __device__ __forceinline__ bool valid(int, int) const { return true; }
    __device__ __forceinline__ int nk(int) const { return 8; }
    __device__ __forceinline__ const bf16_t* arow(int rt, int, int, int r) const { return H + (size_t)(rt * 128 + r) * 512; }
    __device__ __forceinline__ const bf16_t* brow(int rt, int nt, int, int r) const { return W2 + ((size_t)moe_expert(off, rt) * 1024 + nt * 128 + r) * 512; }
    __device__ __forceinline__ void seg_end(int rt, int nt, int, f32x4 (&acc)[4][4]) const {
#pragma unroll
        for (int ni = 0; ni < 4; ++ni)
#pragma unroll
            for (int mi = 0; mi < 4; ++mi) {
                const int m = rt * 128 + wr * 64 + mi * 16 + lr, n = nt * 128 + wc * 64 + ni * 16 + g * 4;
                uint2 o; o.x = pack2(acc[ni][mi][0], acc[ni][mi][1]); o.y = pack2(acc[ni][mi][2], acc[ni][mi][3]);
                *(uint2*)(Y2 + (size_t)m * 1024 + n) = o;
                acc[ni][mi] = (f32x4){0.f, 0.f, 0.f, 0.f};
            }
    }
};
__device__ __forceinline__ void phase_moe_down(const Params& p, unsigned char* lds) {
    int* off = (int*)(lds + LDS_BYTES - 256);
    moe_offsets(p, off);
    const int lane = tidx() & 63, wid = tidx() >> 6;
    PhDown ph{(const bf16_t*)(p.ws + OFF_H), (const bf16_t*)(p.ws + OFF_W2), (bf16_t*)(p.ws + OFF_Y2), off, wid >> 1, wid & 1, lane & 15, lane >> 4};
    const TileSched ts_(off[16] >> 7, 8);
    gemm_stream<4>(ph, ts_, lds);
}

__device__ __forceinline__ void phase_combine(const Params& p, int l) {
    const bf16_t* Y2 = (const bf16_t*)(p.ws + OFF_Y2); const int* TOKPOS = (const int*)(p.ws + OFF_TOKPOS); const float2* RTW = (const float2*)(p.ws + OFF_RTW);
    const float* MOD = (const float*)(p.ws + OFF_MOD);
    const int nrows = l == 0 ? T : TX, lane = tidx() & 63, gw = blockIdx.x * 4 + (tidx() >> 6), nw = gridDim.x * 4;
    for (int row = gw; row < nrows; row += nw) {
        const int p0 = TOKPOS[row * 2], p1 = TOKPOS[row * 2 + 1];
        const float2 w = RTW[row];
        const float* g2p = MOD + (size_t)(l * 9 + mod_row(row)) * 6144 + 5120 + lane * 4;
        float* dst = stream_out_row(p, row) + lane * 4;
        uint2 ya[4], yb[4]; f32x4 xv[4], g2[4];
#pragma unroll
        for (int i = 0; i < 4; ++i) {
            ya[i] = *(const uint2*)(Y2 + (size_t)p0 * 1024 + lane * 4 + i * 256); yb[i] = *(const uint2*)(Y2 + (size_t)p1 * 1024 + lane * 4 + i * 256);
            xv[i] = *(const f32x4*)(dst + i * 256); g2[i] = *(const f32x4*)(g2p + i * 256);
        }
#pragma unroll
        for (int i = 0; i < 4; ++i) {
            f32x4 x = xv[i];
            x[0] += g2[i][0] * (w.x * __uint_as_float(ya[i].x << 16) + w.y * __uint_as_float(yb[i].x << 16));
            x[1] += g2[i][1] * (w.x * __uint_as_float(ya[i].x & 0xffff0000u) + w.y * __uint_as_float(yb[i].x & 0xffff0000u));
            x[2] += g2[i][2] * (w.x * __uint_as_float(ya[i].y << 16) + w.y * __uint_as_float(yb[i].y << 16));
            x[3] += g2[i][3] * (w.x * __uint_as_float(ya[i].y & 0xffff0000u) + w.y * __uint_as_float(yb[i].y & 0xffff0000u));
            *(f32x4*)(dst + i * 256) = x;
        }
    }
}

__device__ __forceinline__ int next_unit(int* counter, unsigned char* lds) {
    int* sh = (int*)(lds + LDS_BYTES - 64);
    __syncthreads();
    if (tidx() == 0) sh[0] = atomicAdd(counter, 1);
    __syncthreads();
    return sh[0];
}
__device__ __forceinline__ void stage_mixA(const Params& p, int l, unsigned char* lds, int role) {
    int* CNT = (int*)(p.ws + OFF_CNT);
    const int nattn = l == 0 ? 2048 + 128 : 2048;
    const int ncommon = nattn + 1024 + 256;
    constexpr int N1 = 4;
    bool did_r = false; int ndone = 0;
    for (;;) {
        int ru = -1, cu = -1;
        if (!did_r && (role == 0 || ndone >= N1)) { did_r = true; ru = next_unit(&CNT[35], lds); if (ru >= 512) continue; }
        else {
            cu = next_unit(&CNT[32], lds);
            if (cu >= ncommon) { cu = -1; ru = next_unit(&CNT[35], lds); if (ru >= 512) break; } else ++ndone;
        }
        if (ru >= 0) rwkv_chunk_unit<0>(p, l, ru, lds);
        else if (cu < nattn) attn_unit(p, l, cu, lds);
        else if (cu < nattn + 1024) lru_chunk_unit<0>(p, l, cu - nattn, lds);
        else hy_norm_unit(p, cu - nattn - 1024, lds);
    }
}
__device__ __forceinline__ void stage_mixB(const Params& p, int l, unsigned char* lds) {
    int* CNT = (int*)(p.ws + OFF_CNT);
    const int nh = l == 0 ? 512 + 256 : 512;
    for (;;) {
        const int u = next_unit(&CNT[33], lds);
        if (u < 64) rwkv_passB_unit(p, u, lds);
        else if (u < 128) lru_passB_unit(p, u - 64);
        else if (u < 128 + 512) hyena_mfma_unit(p, l, u - 128, lds);
        else if (u < 128 + nh) hyena_ctx_unit(p, l, u - 128 - 512, lds);
        else break;
    }
}
__device__ __forceinline__ void stage_mixC(const Params& p, int l, unsigned char* lds) {
    int* CNT = (int*)(p.ws + OFF_CNT);
    for (;;) {
        const int u = next_unit(&CNT[34], lds);
        if (u < 1024) lru_chunk_unit<1>(p, l, u, lds);
        else if (u < 1536) rwkv_passC_unit(p, u - 1024, lds);
        else break;
    }
}
__device__ __forceinline__ void stage_mixD(const Params& p, int l, unsigned char* lds) {
    const int nr = (l == 0 ? T : TX) / 8;
    for (int u = blockIdx.x; u < nr; u += gridDim.x) rwkv_readout_unit(p, l, u, lds);
    phase_lru_combine(p, l);
}

__global__ void __launch_bounds__(NTHR, 2) __attribute__((target("no-packed-fp32-ops"))) fwd_kernel(Params p) {
    extern __shared__ __attribute__((aligned(16))) unsigned char lds[];
    volatile LAS unsigned* xb_words = (volatile LAS unsigned*)(LAS unsigned char*)(lds + LDS_BYTES - 128);
    if (threadIdx.x == 0) { xb_words[0] = 0u; xb_words[1] = 0u; xb_words[2] = 0u; xb_words[3] = 0u; }
    __syncthreads();
    XcdBarrier bar = xcd_barrier_post((unsigned*)(p.ws + OFF_BAR), xb_words);
    if (threadIdx.x == 0) {
        const unsigned key = bar.x * 256u + (((unsigned)__builtin_amdgcn_s_getreg(63492) >> 8) & 0xffu);
        xb_words[2] = (unsigned)atomicAdd((int*)(p.ws + OFF_CUSLOT) + key, 1);
    }
    __syncthreads();
    const int role = (int)(xb_words[2] & 1u);
    typedef __attribute__((address_space(1))) unsigned char gu8_t;
    typedef __attribute__((address_space(1))) float gf32_t;
    Params q;
#pragma unroll
    for (int i = 0; i < 47; ++i) q.in[i] = (const float*)(const gf32_t*)(uintptr_t)p.in[i];
    q.out = (float*)(gf32_t*)(uintptr_t)p.out;
    q.ws = (unsigned char*)(gu8_t*)(uintptr_t)p.ws;
    uintptr_t ws_i = (uintptr_t)p.ws, out_i = (uintptr_t)p.out;
#define LND() do { asm volatile("" : "+s"(ws_i), "+s"(out_i) :: "memory"); q.ws = (unsigned char*)(gu8_t*)ws_i; q.out = (float*)(gf32_t*)out_i; } while (0)
    phase_mod(q, lds);
#pragma unroll 1
    for (int l = 0; l < 2; ++l) {
        LND();
        if (blockIdx.x == 0 && threadIdx.x < 64) ((int*)(q.ws + OFF_CNT))[threadIdx.x] = 0;
        phase_wconv(q, l, lds);
        LND();
        phase_hyf1(q, l);
        xcd_barrier(bar);
        LND();
        phase_hx(q, l);
        LND();
        phase_hyf2(q, l);
        xcd_barrier(bar);
        LND();
        phase_inproj(q, l, lds);
        xcd_barrier(bar);
        LND();
        phase_qk(q, l);
        LND();
        phase_hyprep(q, l, lds);
        LND();
        phase_hyf3(q, l, lds);
        xcd_barrier(bar);
        LND();
        stage_mixA(q, l, lds, role);
        xcd_barrier(bar);
        LND();
        stage_mixB(q, l, lds);
        xcd_barrier(bar);
        LND();
        stage_mixC(q, l, lds);
        xcd_barrier(bar);
        LND();
        stage_mixD(q, l, lds);
        xcd_barrier(bar);
        LND();
        phase_merge(q, l, lds);
        xcd_barrier(bar);
        LND();
        phase_wout(q, l, lds);
        xcd_barrier(bar);
        LND();
        phase_route(q, l, lds);
        LND();
        phase_wconv_moe(q, l, lds);
        xcd_barrier(bar);
        LND();
        phase_lists(q, l, lds);
        xcd_barrier(bar);
        LND();
        phase_moe_up(q, lds);
        xcd_barrier(bar);
        LND();
        phase_moe_down(q, lds);
        xcd_barrier(bar);
        LND();
        phase_combine(q, l);
        xcd_barrier(bar);
    }
#undef LND
}

extern "C" void kernel_launch(void* const* d_in, const int* in_sizes, int n_in, void* d_out, int out_size, void* d_ws, size_t ws_size, hipStream_t stream) {
    (void)in_sizes; (void)out_size;
    if (n_in < 47 || ws_size < WS_NEED) { fprintf(stderr, "kernel_launch: bad inputs (n_in %d, ws %zu < %zu)\n", n_in, ws_size, (size_t)WS_NEED); return; }
    static int grid = 0;
    if (!grid) {
        int dev = 0, cus = 0, per_cu = 0;
        hipGetDevice(&dev);
        hipDeviceGetAttribute(&cus, hipDeviceAttributeMultiprocessorCount, dev);
        hipFuncSetAttribute((const void*)fwd_kernel, hipFuncAttributeMaxDynamicSharedMemorySize, LDS_BYTES);
        hipOccupancyMaxActiveBlocksPerMultiprocessor(&per_cu, fwd_kernel, NTHR, LDS_BYTES);
        if (per_cu > 2) per_cu = 2;
        if (per_cu < 1) per_cu = 1;
        grid = cus * per_cu;
    }
    hipMemsetAsync(d_ws, 0, OFF_CUSLOT + 2048 * sizeof(int), stream);
    Params p{};
    for (int i = 0; i < 47; ++i) p.in[i] = (const float*)d_in[i];
    p.out = (float*)d_out;
    p.ws = (unsigned char*)d_ws;
    hipLaunchKernelGGL(fwd_kernel, dim3(grid), dim3(NTHR), LDS_BYTES, stream, p);
}
```

```cpp
#include <hip/hip_runtime.h>
#include <stdint.h>
#include <math.h>
#include <stdio.h>

typedef unsigned short bf16_t;
typedef short bf16x8 __attribute__((ext_vector_type(8)));
typedef float f32x4 __attribute__((ext_vector_type(4)));
typedef float f32x2 __attribute__((ext_vector_type(2)));
typedef short s16x4 __attribute__((ext_vector_type(4)));

#define NTHR 256
#define LDS_BYTES (73 * 1024)

constexpr int D = 1024, NB = 8, SEQ = 4096, CL = 256;
constexpr int TX = NB * SEQ;
constexpr int TC = NB * CL;
constexpr int T = TX + TC;
constexpr int NP = 3200;
constexpr int QO = 0, KO = 512, VO = 640, HYO = 768, RWO = 1536, LRO = 2688, GTO = 3200, NIN = 7296;
constexpr int NKEY = CL + SEQ;
constexpr int MAXROWS = 2 * T + 16 * 128;

constexpr size_t al(size_t x) { return (x + 255) & ~(size_t)255; }
constexpr size_t OFF_BAR = 0;
constexpr size_t OFF_CNT = 16384;
constexpr size_t OFF_CUSLOT = OFF_CNT + 1024;
constexpr size_t OFF_MOD = OFF_CNT + 16384;
constexpr size_t OFF_NORM = al(OFF_MOD + (size_t)2 * 9 * 6144 * 4);
constexpr size_t OFF_FH1 = al(OFF_NORM + 1024 * 4);
constexpr size_t OFF_FH2 = al(OFF_FH1 + (size_t)4352 * 64 * 4);
constexpr size_t OFF_FILT = al(OFF_FH2 + (size_t)4352 * 64 * 4);
constexpr size_t OFF_WIN = al(OFF_FILT + (size_t)4352 * 1024 * 4);
constexpr size_t OFF_WBR = al(OFF_WIN + (size_t)NIN * 1024 * 2);
constexpr size_t OFF_WOUT = al(OFF_WBR + (size_t)1024 * 1280 * 2);
constexpr size_t OFF_W13 = al(OFF_WOUT + (size_t)1024 * 1024 * 2);
constexpr size_t OFF_W2 = al(OFF_W13 + (size_t)16 * 1024 * 1024 * 2);
constexpr size_t OFF_HX = al(OFF_W2 + (size_t)16 * 1024 * 512 * 2);
constexpr size_t OFF_P = al(OFF_HX + (size_t)T * 1024 * 2);
constexpr size_t OFF_KB = al(OFF_P + (size_t)T * NP * 2);
constexpr size_t OFF_VT = al(OFF_KB + (size_t)16 * NKEY * 64 * 2);
constexpr size_t OFF_YRW = al(OFF_VT + (size_t)16 * NKEY * 64 * 2);
constexpr size_t OFF_RWOUT = al(OFF_YRW + (size_t)2 * T * 256 * 2);
constexpr size_t OFF_HF = al(OFF_RWOUT + (size_t)T * 256 * 2);
constexpr size_t OFF_HF1 = al(OFF_HF + (size_t)T * 256 * 2);
constexpr size_t OFF_CTXS = al(OFF_HF1 + (size_t)T * 256 * 2);
constexpr size_t OFF_RTE = al(OFF_CTXS + (size_t)TC * 1024 * 4);
constexpr size_t OFF_RTW = al(OFF_RTE + (size_t)T * 4);
constexpr size_t OFF_TOKPOS = al(OFF_RTW + (size_t)T * 8);
constexpr size_t OFF_ROWTOK = al(OFF_TOKPOS + (size_t)T * 8);
constexpr size_t OFF_LRAB = al(OFF_ROWTOK + (size_t)MAXROWS * 4);
constexpr size_t OFF_LRH0 = al(OFF_LRAB + (size_t)1024 * 128 * 4);
constexpr size_t OFF_ZTA = al(OFF_LRH0 + (size_t)1024 * 64 * 4);
constexpr size_t OFF_RWL = al(OFF_ZTA + (size_t)8 * 512 * 4096 * 2);
constexpr size_t WS_NEED = al(OFF_RWL + (size_t)2 * 65536);
static_assert(WS_NEED <= (size_t)536870912, "workspace must fit 512 MiB");
constexpr size_t OFF_RWE = OFF_W13;
constexpr size_t OFF_RWS0 = OFF_W2;
constexpr size_t OFF_H = OFF_P;
constexpr size_t OFF_Y2 = al(OFF_P + (size_t)MAXROWS * 512 * 2);
static_assert(OFF_Y2 + (size_t)MAXROWS * 1024 * 2 <= OFF_KB, "MoE buffers must fit inside P");

struct Params {
    const float* in[47];
    float* out;
    unsigned char* ws;
};

__device__ __forceinline__ float bf2f(bf16_t v) { return __uint_as_float(((unsigned)v) << 16); }
__device__ __forceinline__ bf16_t f2bf(float f) { return __builtin_bit_cast(bf16_t, (__bf16)f); }
typedef __bf16 bf16x2_t __attribute__((ext_vector_type(2)));
__device__ __forceinline__ unsigned pack2(float a, float b) { const f32x2 v = {a, b}; return __builtin_bit_cast(unsigned, __builtin_convertvector(v, bf16x2_t)); }
typedef unsigned u32x2_t __attribute__((ext_vector_type(2)));
__device__ __forceinline__ float wave_sum(float v) {
    v += __int_as_float(__builtin_amdgcn_update_dpp(0, __float_as_int(v), 0xB1, 0xf, 0xf, true));
    v += __int_as_float(__builtin_amdgcn_update_dpp(0, __float_as_int(v), 0x4E, 0xf, 0xf, true));
    v += __int_as_float(__builtin_amdgcn_update_dpp(0, __float_as_int(v), 0x141, 0xf, 0xf, true));
    v += __int_as_float(__builtin_amdgcn_update_dpp(0, __float_as_int(v), 0x140, 0xf, 0xf, true));
    const unsigned a = __float_as_uint(v);
    const u32x2_t r = __builtin_amdgcn_permlane16_swap(a, a, false, false);
    const float s = __uint_as_float(r[0]) + __uint_as_float(r[1]);
    const unsigned w = __float_as_uint(s);
    const u32x2_t q = __builtin_amdgcn_permlane32_swap(w, w, false, false);
    return __uint_as_float(q[0]) + __uint_as_float(q[1]);
}
__device__ __forceinline__ float sigmoidf_(float x) { return __builtin_amdgcn_rcpf(1.0f + __expf(-x)); }
__device__ __forceinline__ float tanh_fast(float x) { return 1.0f - 2.0f * __builtin_amdgcn_rcpf(1.0f + __expf(2.0f * x)); }
__device__ __forceinline__ float softplusf_(float x) { return x > 20.f ? x : log1pf(expf(x)); }

#define XB_TMO      128
#define XB_XCNT(j)  (256  + 64 * (j))
#define XB_XSUB(j)  (1280 + 64 * (j))
#define XB_XGEN(j)  (2304 + 64 * (j))
#define XB_TOP      3328
#define XB_TOPGEN   3392
#define XCD_BAR_WORDS 3456
#define XB_SPIN_CAP (1u << 22)
#define LAS __attribute__((address_space(3)))

__device__ __forceinline__ unsigned xb_ld(unsigned* p)              { return __hip_atomic_load(p, __ATOMIC_RELAXED, __HIP_MEMORY_SCOPE_AGENT); }
__device__ __forceinline__ unsigned xb_add(unsigned* p, unsigned v) { return __hip_atomic_fetch_add(p, v, __ATOMIC_RELAXED, __HIP_MEMORY_SCOPE_AGENT); }
__device__ __forceinline__ unsigned xb_xcc_id() { return (unsigned)__builtin_amdgcn_s_getreg((3 << 11) | 20) & 0xFu; }
#define XB_SPIN(cond, bar) do { unsigned _sp = 0; while (cond) { __builtin_amdgcn_s_sleep(1); \
    if ((++_sp & 255u) == 0u) { if (xb_ld(&(bar)[XB_TMO])) break; if (_sp > XB_SPIN_CAP) { atomicAdd(&(bar)[XB_TMO], 1u); break; } } } } while (0)

struct XcdBarrier { unsigned* bar; unsigned x; volatile LAS unsigned* st; };

__device__ __forceinline__ XcdBarrier xcd_barrier_post(unsigned* bar, volatile LAS unsigned* st) {
    XcdBarrier b; b.bar = bar; b.x = xb_xcc_id(); b.st = st;
    if (threadIdx.x == 0) (void)xb_add(&bar[XB_XCNT(b.x)], 1u);
    return b;
}
__device__ __forceinline__ void xcd_barrier_complete(unsigned* bar, unsigned x, unsigned& nloc, unsigned& nx) {
    const unsigned G = gridDim.x * gridDim.y * gridDim.z;
    unsigned sum, cnt, mine, sp = 0u;
    for (;;) {
        sum = 0u; cnt = 0u; mine = 0u;
#pragma unroll
        for (unsigned j = 0; j < 16; ++j) { const unsigned c = xb_ld(&bar[XB_XCNT(j)]); sum += c; cnt += (c > 0u) ? 1u : 0u; mine = (j == x) ? c : mine; }
        if (sum == G) break;
        __builtin_amdgcn_s_sleep(1);
        if ((++sp & 255u) == 0u) { if (xb_ld(&bar[XB_TMO])) break; if (sp > XB_SPIN_CAP) { atomicAdd(&bar[XB_TMO], 1u); break; } }
    }
    nloc = mine > 0u ? mine : 1u; nx = cnt > 0u ? cnt : 1u;
}
__device__ __forceinline__ void xcd_barrier(const XcdBarrier& b) {
    asm volatile("s_waitcnt vmcnt(0)" ::: "memory");
    __syncthreads();
    if (threadIdx.x == 0) {
        unsigned* bar = b.bar;
        __builtin_amdgcn_s_waitcnt(0);
        unsigned nloc = b.st[0], nx = b.st[1];
        if (nloc == 0u) { xcd_barrier_complete(bar, b.x, nloc, nx); b.st[0] = nloc; b.st[1] = nx; }
        const unsigned old = xb_add(&bar[XB_XSUB(b.x)], 1u);
        const unsigned gen = old / nloc;
        if (old + 1u == (gen + 1u) * nloc) {
            __builtin_amdgcn_fence(__ATOMIC_RELEASE, "agent");
            asm volatile("s_waitcnt vmcnt(0)" ::: "memory");
            const unsigned og = xb_add(&bar[XB_TOP], 1u);
            const unsigned tg = og / nx;
            if (og + 1u == (tg + 1u) * nx) xb_add(&bar[XB_TOPGEN], 1u);
            else XB_SPIN(xb_ld(&bar[XB_TOPGEN]) == tg, bar);
            __builtin_amdgcn_fence(__ATOMIC_ACQUIRE, "agent");
            xb_add(&bar[XB_XGEN(b.x)], 1u);
            asm volatile("s_waitcnt vmcnt(0)" ::: "memory");
        } else {
            XB_SPIN(xb_ld(&bar[XB_XGEN(b.x)]) == gen, bar);
            __builtin_amdgcn_fence(__ATOMIC_ACQUIRE, "agent");
            asm volatile("s_waitcnt vmcnt(0)" ::: "memory");
        }
    }
    __syncthreads();
}

__device__ __forceinline__ int tidx() { int t = threadIdx.x; asm volatile("" : "+v"(t)); return t; }

__device__ __forceinline__ void scan_pos(int b, int d, int pos, int& row, int& t, int& n) {
    if (pos < CL) { t = d ? (CL - 1 - pos) : pos; n = CL; row = TX + b * CL + t; }
    else { const int q = pos - CL; t = d ? (SEQ - 1 - q) : q; n = SEQ; row = b * SEQ + t; }
}
__device__ __forceinline__ int mod_row(int row) { return row < TX ? (row >> 12) : 8; }

template <int NI>
__device__ __forceinline__ void zero_acc(f32x4 (&acc)[NI][4]) {
#pragma unroll
    for (int ni = 0; ni < NI; ++ni)
#pragma unroll
        for (int mi = 0; mi < 4; ++mi) acc[ni][mi] = (f32x4){0.f, 0.f, 0.f, 0.f};
}

struct TileSched {
    int Nt, Px, x, rank, nblk, total;
    __device__ __forceinline__ TileSched(int Mt, int Nt_) {
        int bx = blockIdx.x, gd = gridDim.x; asm volatile("" : "+s"(bx), "+s"(gd));
        Nt = Nt_; x = bx & 7; rank = bx >> 3; nblk = (gd - x + 7) >> 3;
        Px = x < Mt ? (Mt - x + 7) >> 3 : 0; total = Px * Nt;
    }
    __device__ __forceinline__ void decode(int e, int& mt, int& nt) const {
        const int pg = 8 * Nt;
        int grp = e / pg; const int ngf = Px >> 3; if (grp > ngf) grp = ngf;
        const int r = e - grp * pg;
        const int gm = (Px - 8 * grp) < 8 ? (Px - 8 * grp) : 8;
        const int nbf = Nt >> 3;
        int nb = r / (gm * 8), w = 8, q2;
        if (nb >= nbf) { nb = nbf; w = Nt - 8 * nbf; q2 = r - nbf * gm * 8; } else q2 = r - nb * gm * 8;
        const int m_in = q2 / w, n_in = q2 - m_in * w;
        mt = x + 8 * (8 * grp + m_in); nt = 8 * nb + n_in;
    }
};

struct GCur { int e, mt, nt; };
template <class PH>
__device__ __forceinline__ bool gs_advance(const PH& ph, const TileSched& ts, GCur& c, bool first) {
    c.e = first ? ts.rank : c.e + ts.nblk;
    while (c.e < ts.total) { ts.decode(c.e, c.mt, c.nt); if (ph.valid(c.mt, c.nt)) return true; c.e += ts.nblk; }
    return false;
}
template <int NI, class PH>
__device__ __forceinline__ void gemm_stream(PH& ph, const TileSched& ts, unsigned char* lds) {
    constexpr int STG = 256 * 64;
    bf16_t* L = (bf16_t*)lds;
    const int tid = tidx(), lane = tid & 63, wid = tid >> 6, wr = wid >> 1, wc = wid & 1, lr = lane & 15, g = lane >> 4;
    const int crow = tid >> 3;
    const int kcs = ((tid & 7) ^ ((crow >> 1) & 7)) * 8;
    const int sw = (lr >> 1) & 7;
    const int p0 = (g ^ sw) << 3, p1 = ((g + 4) ^ sw) << 3;
    const int ao = (wr * 64 + lr) * 64, bo = (128 + wc * 16 * NI + lr) * 64;
    GCur lc; int lseg = 0, lkt = 0, lnk = 0; bool lex;
    const bf16_t *la0 = nullptr, *la1 = nullptr, *la2 = nullptr, *la3 = nullptr, *lb0 = nullptr; int lsb = 0;
    lex = !gs_advance(ph, ts, lc, true);
    if (lex) return;
#define GS_SETUP() do { lnk = ph.nk(lseg); \
        la0 = ph.arow(lc.mt, lc.nt, lseg, crow) + kcs; la1 = ph.arow(lc.mt, lc.nt, lseg, crow + 32) + kcs; \
        la2 = ph.arow(lc.mt, lc.nt, lseg, crow + 64) + kcs; la3 = ph.arow(lc.mt, lc.nt, lseg, crow + 96) + kcs; \
        lb0 = ph.brow(lc.mt, lc.nt, lseg, crow) + kcs; \
        lsb = __builtin_amdgcn_readfirstlane((int)(ph.brow(lc.mt, lc.nt, lseg, crow + 32) - ph.brow(lc.mt, lc.nt, lseg, crow))); } while (0)
#define GS_GLDS(gp, eo) __builtin_amdgcn_global_load_lds((const __attribute__((address_space(1))) unsigned*)(gp), (LAS unsigned*)(D_ + (eo)), 16, 0, 0)
#define GS_DMA(st) do { if (!lex) { const int ko = lkt * 64; bf16_t* D_ = L + (st) * STG + tid * 8; \
        GS_GLDS(la0 + ko, 0); GS_GLDS(la1 + ko, 2048); GS_GLDS(la2 + ko, 4096); GS_GLDS(la3 + ko, 6144); \
        GS_GLDS(lb0 + ko, 8192); GS_GLDS(lb0 + lsb + ko, 10240); \
        if (NI > 2) { GS_GLDS(lb0 + 2 * lsb + ko, 12288); GS_GLDS(lb0 + 3 * lsb + ko, 14336); } \
        if (++lkt == lnk) { lkt = 0; if (++lseg == ph.nseg) { lseg = 0; lex = !gs_advance(ph, ts, lc, false); } if (!lex) GS_SETUP(); } } } while (0)
#define GS_COMPUTE(st) do { const bf16_t* cur = L + (st) * STG; \
        _Pragma("unroll") for (int ks = 0; ks < 2; ++ks) { \
            const int pk = ks ? p1 : p0; \
            bf16x8 af[4], wf[NI]; \
            _Pragma("unroll") for (int mi = 0; mi < 4; ++mi) af[mi] = *(const bf16x8*)(cur + ao + mi * 16 * 64 + pk); \
            _Pragma("unroll") for (int ni = 0; ni < NI; ++ni) wf[ni] = *(const bf16x8*)(cur + bo + ni * 16 * 64 + pk); \
            __builtin_amdgcn_s_setprio(1); \
            _Pragma("unroll") for (int ni = 0; ni < NI; ++ni) \
                _Pragma("unroll") for (int mi = 0; mi < 4; ++mi) acc[ni][mi] = __builtin_amdgcn_mfma_f32_16x16x32_bf16(wf[ni], af[mi], acc[ni][mi], 0, 0, 0); \
            __builtin_amdgcn_s_setprio(0); \
        } } while (0)
    GS_SETUP();
    GCur cc = lc; int cseg = 0, ckt = 0, cnk = ph.nk(0);
    f32x4 acc[NI][4]; zero_acc<NI>(acc);
    __syncthreads();
    GS_DMA(0);
    GS_DMA(1);
    asm volatile("s_waitcnt vmcnt(0)" ::: "memory");
    __syncthreads();
#pragma unroll 1
    for (;;) {
        GS_COMPUTE(0);
        asm volatile("s_waitcnt vmcnt(0)" ::: "memory");
        __syncthreads();
        GS_DMA(0);
        GS_COMPUTE(1);
        asm volatile("s_waitcnt vmcnt(0)" ::: "memory");
        __syncthreads();
        GS_DMA(1);
        ckt += 2;
        if (ckt == cnk) {
            ph.seg_end(cc.mt, cc.nt, cseg, acc);
            ckt = 0;
            if (++cseg == ph.nseg) { cseg = 0; if (!gs_advance(ph, ts, cc, false)) break; }
            cnk = ph.nk(cseg);
        }
    }
    __syncthreads();
#undef GS_SETUP
#undef GS_GLDS
#undef GS_DMA
#undef GS_COMPUTE
}

__device__ __forceinline__ void phase_mod(const Params& p, unsigned char* lds) {
    float* s = (float*)lds;
    float* red = s + 9 * 1024;
    const int tid = tidx();
    const float* c = p.in[1]; const float* cc = p.in[3];
    for (int i = tid; i < 9 * 1024; i += NTHR) { const int r = i >> 10, k = i & 1023; const float v = r < 8 ? c[r * 1024 + k] : cc[k]; s[i] = v / (1.0f + expf(-v)); }
    __syncthreads();
    float* MOD = (float*)(p.ws + OFF_MOD);
    const int cg = tid & 31, kg = tid >> 5;
    for (int u = blockIdx.x; u < 2 * 6144 / 32; u += gridDim.x) {
        const int col = u * 32 + cg, l = col / 6144, j = col % 6144;
        const float* w = p.in[4] + (size_t)l * 1024 * 6144 + j;
        float acc[9];
#pragma unroll
        for (int r = 0; r < 9; ++r) acc[r] = 0.f;
        for (int k = kg * 128; k < kg * 128 + 128; ++k) {
            const float wv = w[(size_t)k * 6144];
#pragma unroll
            for (int r = 0; r < 9; ++r) acc[r] += s[r * 1024 + k] * wv;
        }
#pragma unroll
        for (int r = 0; r < 9; ++r) red[(kg * 32 + cg) * 9 + r] = acc[r];
        __syncthreads();
        for (int i = tid; i < 32 * 9; i += NTHR) {
            const int c2 = i / 9, r = i % 9; float a = 0.f;
#pragma unroll
            for (int q = 0; q < 8; ++q) a += red[(q * 32 + c2) * 9 + r];
            const int col2 = u * 32 + c2, l2 = col2 / 6144, j2 = col2 % 6144;
            MOD[(size_t)(l2 * 9 + r) * 6144 + j2] = a + p.in[5][l2 * 6144 + j2];
        }
        __syncthreads();
    }
}

__device__ __forceinline__ void tconv(const float* __restrict__ src, int K, int N, bf16_t* __restrict__ dst, int ldd, int coff, int mode, float* tile, int& ucnt) {
    const int tid = tidx();
    const int nkt = K >> 6, nnt = N >> 6, ntile = nkt * nnt;
    const int G_ = (int)gridDim.x;
    int first = ((int)blockIdx.x - ucnt % G_ + G_) % G_;
    ucnt += ntile;
    for (int tt = first; tt < ntile; tt += G_) {
        const int k0 = (tt / nnt) * 64, n0 = (tt % nnt) * 64;
        __syncthreads();
#pragma unroll
        for (int i = 0; i < 4; ++i) {
            const int q = tid + i * NTHR, r = q >> 4, c4 = (q & 15) * 4;
            const f32x4 v = *(const f32x4*)(src + (size_t)(k0 + r) * N + n0 + c4);
            tile[r * 65 + c4] = v[0]; tile[r * 65 + c4 + 1] = v[1]; tile[r * 65 + c4 + 2] = v[2]; tile[r * 65 + c4 + 3] = v[3];
        }
        __syncthreads();
#pragma unroll
        for (int i = 0; i < 2; ++i) {
            const int q = tid + i * NTHR, nl = q >> 3, kc8 = (q & 7) * 8, nn = n0 + nl;
            const int drow = mode == 0 ? nn : ((nn >> 4) * 32 + (mode == 2 ? 16 : 0) + (nn & 15));
            uint4 o;
            o.x = pack2(tile[(kc8 + 0) * 65 + nl], tile[(kc8 + 1) * 65 + nl]); o.y = pack2(tile[(kc8 + 2) * 65 + nl], tile[(kc8 + 3) * 65 + nl]);
            o.z = pack2(tile[(kc8 + 4) * 65 + nl], tile[(kc8 + 5) * 65 + nl]); o.w = pack2(tile[(kc8 + 6) * 65 + nl], tile[(kc8 + 7) * 65 + nl]);
            *(uint4*)(dst + (size_t)drow * ldd + coff + k0 + kc8) = o;
        }
    }
}
__device__ __forceinline__ void phase_wconv(const Params& p, int l, unsigned char* lds) {
    float* tile = (float*)lds;
    int ucnt = 0;
    tconv(p.in[6] + (size_t)l * 1024 * NIN, 1024, NIN, (bf16_t*)(p.ws + OFF_WIN), 1024, 0, 0, tile, ucnt);
    tconv(p.in[35] + (size_t)l * 512 * 1024, 512, 1024, (bf16_t*)(p.ws + OFF_WBR), 1280, 0, 0, tile, ucnt);
    tconv(p.in[36] + (size_t)l * 256 * 1024, 256, 1024, (bf16_t*)(p.ws + OFF_WBR), 1280, 512, 0, tile, ucnt);
    tconv(p.in[37] + (size_t)l * 256 * 1024, 256, 1024, (bf16_t*)(p.ws + OFF_WBR), 1280, 768, 0, tile, ucnt);
    tconv(p.in[38] + (size_t)l * 256 * 1024, 256, 1024, (bf16_t*)(p.ws + OFF_WBR), 1280, 1024, 0, tile, ucnt);
    tconv(p.in[39] + (size_t)l * 1024 * 1024, 1024, 1024, (bf16_t*)(p.ws + OFF_WOUT), 1024, 0, 0, tile, ucnt);
    tconv(p.in[21] + (size_t)(l * 2 + 0) * 64 * 256, 64, 256, (bf16_t*)(p.ws + OFF_RWL), 64, 0, 0, tile, ucnt);
    tconv(p.in[21] + (size_t)(l * 2 + 1) * 64 * 256, 64, 256, (bf16_t*)(p.ws + OFF_RWL) + 256 * 64, 64, 0, 0, tile, ucnt);
    tconv(p.in[22] + (size_t)l * 128 * 256, 128, 256, (bf16_t*)(p.ws + OFF_RWL) + 2 * 256 * 64, 128, 0, 0, tile, ucnt);
    __syncthreads();
}
__device__ __forceinline__ void phase_wconv_moe(const Params& p, int l, unsigned char* lds) {
    float* tile = (float*)lds;
    int ucnt = 0;
#pragma unroll 1
    for (int e = 0; e < 16; ++e) {
        tconv(p.in[44] + ((size_t)l * 16 + e) * 1024 * 512, 1024, 512, (bf16_t*)(p.ws + OFF_W13) + (size_t)e * 1024 * 1024, 1024, 0, 1, tile, ucnt);
        tconv(p.in[45] + ((size_t)l * 16 + e) * 1024 * 512, 1024, 512, (bf16_t*)(p.ws + OFF_W13) + (size_t)e * 1024 * 1024, 1024, 0, 2, tile, ucnt);
        tconv(p.in[46] + ((size_t)l * 16 + e) * 512 * 1024, 512, 1024, (bf16_t*)(p.ws + OFF_W2) + (size_t)e * 1024 * 512, 512, 0, 0, tile, ucnt);
    }
    __syncthreads();
}

__device__ __forceinline__ const float* stream_in_row(const Params& p, int l, int row) {
    if (row < TX) return (l == 0 ? p.in[0] : p.out) + (size_t)row * D;
    return (l == 0 ? p.in[2] : (const float*)(p.ws + OFF_CTXS)) + (size_t)(row - TX) * D;
}
__device__ __forceinline__ float* stream_out_row(const Params& p, int row) {
    if (row < TX) return p.out + (size_t)row * D;
    return (float*)(p.ws + OFF_CTXS) + (size_t)(row - TX) * D;
}

__device__ __forceinline__ void phase_hx(const Params& p, int l) {
    const int lane = tidx() & 63, gw = blockIdx.x * 4 + (tidx() >> 6), nw = gridDim.x * 4;
    bf16_t* HX = (bf16_t*)(p.ws + OFF_HX);
    const float* MOD = (const float*)(p.ws + OFF_MOD);
    for (int row0 = gw * 2; row0 < T; row0 += nw * 2) {
        f32x4 v[2][4]; float ss[2] = {0.f, 0.f};
#pragma unroll
        for (int rr = 0; rr < 2; ++rr) {
            const float* src = stream_in_row(p, l, row0 + rr);
#pragma unroll
            for (int i = 0; i < 4; ++i) v[rr][i] = *(const f32x4*)(src + i * 256 + lane * 4);
        }
#pragma unroll
        for (int rr = 0; rr < 2; ++rr) {
#pragma unroll
            for (int i = 0; i < 4; ++i) ss[rr] += v[rr][i][0] * v[rr][i][0] + v[rr][i][1] * v[rr][i][1] + v[rr][i][2] * v[rr][i][2] + v[rr][i][3] * v[rr][i][3];
            ss[rr] = wave_sum(ss[rr]);
        }
#pragma unroll
        for (int rr = 0; rr < 2; ++rr) {
            const int row = row0 + rr;
            const float rstd = rsqrtf(ss[rr] * (1.0f / 1024.0f) + 1e-6f);
            const float* mod = MOD + (size_t)(l * 9 + mod_row(row)) * 6144;
#pragma unroll
            for (int i = 0; i < 4; ++i) {
                const int k = i * 256 + lane * 4;
                const f32x4 sh = *(const f32x4*)(mod + k), sc = *(const f32x4*)(mod + 1024 + k);
                uint2 o;
                o.x = pack2(v[rr][i][0] * rstd * (1.f + sc[0]) + sh[0], v[rr][i][1] * rstd * (1.f + sc[1]) + sh[1]);
                o.y = pack2(v[rr][i][2] * rstd * (1.f + sc[2]) + sh[2], v[rr][i][3] * rstd * (1.f + sc[3]) + sh[3]);
                *(uint2*)(HX + (size_t)row * 1024 + k) = o;
            }
        }
    }
}

__device__ __forceinline__ void phase_hyf1(const Params& p, int l) {
    float* FH1 = (float*)(p.ws + OFF_FH1);
    const float* f1 = p.in[11] + (size_t)l * 33 * 64; const float* fb1 = p.in[12] + l * 64;
    for (int i = blockIdx.x * NTHR + tidx(); i < 4352 * 64; i += gridDim.x * NTHR) {
        const int r = i >> 6, j = i & 63;
        const float tau = r < 4096 ? (float)r * (1.0f / 4096.0f) : (float)(r - 4096) * (1.0f / 256.0f);
        float a = fb1[j] + tau * f1[j];
        for (int q = 0; q < 16; ++q) {
            const float rev = tau * (float)(q + 1);
            a += __builtin_amdgcn_sinf(rev) * f1[(1 + q) * 64 + j] + __builtin_amdgcn_cosf(rev) * f1[(17 + q) * 64 + j];
        }
        FH1[i] = sinf(a);
    }
}
__device__ __forceinline__ void phase_hyf2(const Params& p, int l) {
    const float* FH1 = (const float*)(p.ws + OFF_FH1); float* FH2 = (float*)(p.ws + OFF_FH2);
    const float* f2 = p.in[13] + (size_t)l * 64 * 64; const float* fb2 = p.in[14] + l * 64;
    for (int i = blockIdx.x * NTHR + tidx(); i < 4352 * 64; i += gridDim.x * NTHR) {
        const int r = i >> 6, j = i & 63;
        float a = fb2[j];
        for (int q = 0; q < 64; ++q) a += FH1[r * 64 + q] * f2[q * 64 + j];
        FH2[i] = sinf(a);
    }
}
__device__ __forceinline__ void phase_hyf3(const Params& p, int l, unsigned char* lds) {
    const float* FH2 = (const float*)(p.ws + OFF_FH2); float* F = (float*)(p.ws + OFF_FILT);
    const float* f3 = p.in[15] + (size_t)l * 64 * 1024;
    const float lo = 4.605170185988091f / 1.5f, hi = 4.605170185988091f / 0.3f;
    bf16_t* hs = (bf16_t*)lds;
    bf16_t* wT = hs + 64 * 72;
    const int tid = tidx(), lane = tid & 63, wid = tid >> 6, lr = lane & 15, g = lane >> 4;
    for (int u = blockIdx.x; u < 68 * 16; u += gridDim.x) {
        const int tt = u >> 4, ct = u & 15, r0 = tt * 64, col0 = ct * 64;
        __syncthreads();
        for (int i = tid; i < 2048; i += NTHR) {
            const int t = i >> 5, q2 = (i & 31) * 2;
            const float2 hv = *(const float2*)(FH2 + (size_t)(r0 + t) * 64 + q2);
            *(unsigned*)(hs + t * 72 + q2) = pack2(hv.x, hv.y);
            const int qq = (i >> 6) * 2, cl = i & 63;
            *(unsigned*)(wT + cl * 72 + qq) = pack2(f3[(size_t)qq * 1024 + col0 + cl], f3[(size_t)(qq + 1) * 1024 + col0 + cl]);
        }
        __syncthreads();
        const int col = col0 + wid * 16 + lr, c = col & 255;
        const float delta = lo + (hi - lo) * ((float)c * (1.0f / 255.0f));
        bf16x8 bf[2];
#pragma unroll
        for (int ks = 0; ks < 2; ++ks) bf[ks] = *(const bf16x8*)(wT + (wid * 16 + lr) * 72 + ks * 32 + g * 8);
#pragma unroll
        for (int rt = 0; rt < 4; ++rt) {
            f32x4 acc = {0.f, 0.f, 0.f, 0.f};
#pragma unroll
            for (int ks = 0; ks < 2; ++ks) acc = __builtin_amdgcn_mfma_f32_16x16x32_bf16(*(const bf16x8*)(hs + (rt * 16 + lr) * 72 + ks * 32 + g * 8), bf[ks], acc, 0, 0, 0);
            const int r = r0 + rt * 16 + 4 * g;
            const bool isx = r < 4096;
            const int t = isx ? r : r - 4096;
            const float ts = isx ? (1.0f / 4096.0f) : (1.0f / 256.0f);
            f32x4 o;
#pragma unroll
            for (int j = 0; j < 4; ++j) o[j] = acc[j] * __expf(-(float)(t + j) * ts * delta);
            *(f32x4*)(F + (isx ? (size_t)col * 4096 + t : (size_t)4096 * 1024 + (size_t)col * 256 + t)) = o;
        }
    }
    __syncthreads();
}
__device__ __forceinline__ void hy_norm_unit(const Params& p, int u, unsigned char* lds) {
    const float* F = (const float*)(p.ws + OFF_FILT); float* NORM = (float*)(p.ws + OFF_NORM);
    const int tid = tidx(), lane = tid & 63, id = u * 4 + (tid >> 6);
    const int var = id >> 9, o = (id >> 8) & 1, c = id & 255;
    const int n = var ? 256 : 4096;
    const float* f0 = F + (var ? (size_t)4096 * 1024 : 0) + (size_t)(o * 512 + c) * n;
    const float* f1 = f0 + (size_t)256 * n;
    float s = 0.f;
    for (int t = lane; t < n; t += 64) s += fabsf(f0[t]) + fabsf(f1[t]);
    s = wave_sum(s);
    if (lane == 0) NORM[id] = s;
}


__device__ __forceinline__ float row_sum4(float x) {
    const unsigned v = __float_as_uint(x);
    const u32x2_t r = __builtin_amdgcn_permlane16_swap(v, v, false, false);
    const float s = __uint_as_float(r[0]) + __uint_as_float(r[1]);
    const unsigned w = __float_as_uint(s);
    const u32x2_t q = __builtin_amdgcn_permlane32_swap(w, w, false, false);
    return __uint_as_float(q[0]) + __uint_as_float(q[1]);
}
struct PhInproj {
    const bf16_t* HX; const bf16_t* WIN; bf16_t* P; int l; int wr, wc, lr, g;
    bf16_t* KB; bf16_t* VT; const float* qgain; const float* kgain; unsigned char* ws;
    static constexpr int nseg = 1;
    __device__ __forceinline__ bool valid(int mt, int nt) const { return !(l == 1 && mt >= 256 && !(nt == 4 || nt == 5 || nt >= 12)); }
    __device__ __forceinline__ int nk(int) const { return 16; }
    __device__ __forceinline__ const bf16_t* arow(int mt, int, int, int r) const { return HX + (size_t)(mt * 128 + r) * 1024; }
    __device__ __forceinline__ const bf16_t* brow(int, int nt, int, int r) const { return WIN + (size_t)(nt * 128 + r) * 1024; }
    __device__ __forceinline__ void seg_end(int mt, int nt, int, f32x4 (&acc)[4][4]) const {
        if (nt < 6) {
            const float* gains = nt < 4 ? qgain : kgain;
            f32x4 gn[4]; float fr[4];
#pragma unroll
            for (int ni = 0; ni < 4; ++ni) gn[ni] = *(const f32x4*)(gains + 16 * ni + 4 * g);
#pragma unroll
            for (int j = 0; j < 4; ++j) fr[j] = exp2f(-(float)(4 * g + j) * (13.287712379549449f / 16.0f)) * 0.15915494309189535f;
#pragma unroll
            for (int mi = 0; mi < 4; ++mi) {
                const int m = mt * 128 + wr * 64 + mi * 16 + lr;
                const bool isx = m < TX;
                int b, key, t = 0;
                if (isx) { b = m >> 12; t = m & 4095; key = CL + t; } else { const int rc = m - TX; b = rc >> 8; key = rc & 255; }
                if (nt == 5) {
                    bf16_t* vp = VT + ((size_t)(b * 2 + wc) * 64 + 4 * g) * NKEY + key;
#pragma unroll
                    for (int ni = 0; ni < 4; ++ni)
#pragma unroll
                        for (int j = 0; j < 4; ++j) vp[(size_t)(16 * ni + j) * NKEY] = f2bf(acc[ni][mi][j]);
                } else {
                    float ss = 0.f;
#pragma unroll
                    for (int ni = 0; ni < 4; ++ni) ss += acc[ni][mi][0] * acc[ni][mi][0] + acc[ni][mi][1] * acc[ni][mi][1] + acc[ni][mi][2] * acc[ni][mi][2] + acc[ni][mi][3] * acc[ni][mi][3];
                    ss = row_sum4(ss);
                    const float rn = rsqrtf(ss * (1.0f / 64.0f) + 1e-6f) * (nt < 4 ? 0.125f * 1.4426950408889634f : 1.0f);
                    f32x4 nv[4];
#pragma unroll
                    for (int ni = 0; ni < 4; ++ni) nv[ni] = acc[ni][mi] * rn * gn[ni];
                    if (isx) {
#pragma unroll
                        for (int pr = 0; pr < 2; ++pr) {
                            const float pos = pr == 0 ? (float)(t >> 6) : (float)(t & 63);
#pragma unroll
                            for (int j = 0; j < 4; ++j) {
                                const float rev = pos * fr[j], cs = __builtin_amdgcn_cosf(rev), sn = __builtin_amdgcn_sinf(rev);
                                const float a = nv[2 * pr][j], b2 = nv[2 * pr + 1][j];
                                nv[2 * pr][j] = a * cs - b2 * sn; nv[2 * pr + 1][j] = a * sn + b2 * cs;
                            }
                        }
                    }
                    bf16_t* dst = nt < 4 ? P + (size_t)m * NP + nt * 128 + wc * 64 + 4 * g : KB + ((size_t)(b * 2 + wc) * NKEY + key) * 64 + 4 * g;
#pragma unroll
                    for (int ni = 0; ni < 4; ++ni) { uint2 o; o.x = pack2(nv[ni][0], nv[ni][1]); o.y = pack2(nv[ni][2], nv[ni][3]); *(uint2*)(dst + 16 * ni) = o; }
                }
#pragma unroll
                for (int ni = 0; ni < 4; ++ni) acc[ni][mi] = (f32x4){0.f, 0.f, 0.f, 0.f};
            }
            return;
        }
        if (nt < 12) {
            const int hc0 = nt * 128 + wc * 64 - 768;
#pragma unroll
            for (int mi = 0; mi < 4; ++mi) {
                const int m = mt * 128 + wr * 64 + mi * 16 + lr;
                bf16_t* dst; size_t cs;
                if (m < TX) {
                    const int b = m >> 12, t = m & 4095; cs = 4096;
                    dst = (hc0 < 512 ? (bf16_t*)(ws + OFF_ZTA) + ((size_t)b * 512 + hc0 + 4 * g) * 4096 : (bf16_t*)(ws + OFF_RWOUT) + ((size_t)b * 256 + (hc0 - 512) + 4 * g) * 4096) + t;
                } else {
                    const int rc = m - TX, b = rc >> 8, t = rc & 255; cs = 256;
                    dst = (bf16_t*)(ws + OFF_HF) + ((size_t)b * 768 + hc0 + 4 * g) * 256 + t;
                }
#pragma unroll
                for (int ni = 0; ni < 4; ++ni) {
#pragma unroll
                    for (int j = 0; j < 4; ++j) dst[(size_t)(16 * ni + j) * cs] = f2bf(acc[ni][mi][j]);
                    acc[ni][mi] = (f32x4){0.f, 0.f, 0.f, 0.f};
                }
            }
            return;
        }
#pragma unroll
        for (int ni = 0; ni < 4; ++ni)
#pragma unroll
            for (int mi = 0; mi < 4; ++mi) {
                const int m = mt * 128 + wr * 64 + mi * 16 + lr, n = nt * 128 + wc * 64 + ni * 16 + g * 4;
                uint2 o; o.x = pack2(acc[ni][mi][0], acc[ni][mi][1]); o.y = pack2(acc[ni][mi][2], acc[ni][mi][3]);
                *(uint2*)(P + (size_t)m * NP + n) = o;
                acc[ni][mi] = (f32x4){0.f, 0.f, 0.f, 0.f};
            }
    }
};
__device__ __forceinline__ void phase_inproj(const Params& p, int l, unsigned char* lds) {
    const int lane = tidx() & 63, wid = tidx() >> 6;
    PhInproj ph{(const bf16_t*)(p.ws + OFF_HX), (const bf16_t*)(p.ws + OFF_WIN), (bf16_t*)(p.ws + OFF_P), l, wid >> 1, wid & 1, lane & 15, lane >> 4,
                (bf16_t*)(p.ws + OFF_KB), (bf16_t*)(p.ws + OFF_VT), p.in[7] + l * 64, p.in[8] + l * 64, p.ws};
    const TileSched ts_(272, 25);
    gemm_stream<4>(ph, ts_, lds);
}

__device__ __forceinline__ void phase_qk(const Params& p, int l) {
    bf16_t* P = (bf16_t*)(p.ws + OFF_P); bf16_t* KB = (bf16_t*)(p.ws + OFF_KB); bf16_t* VT = (bf16_t*)(p.ws + OFF_VT);
    const int lane = tidx() & 63, gw = blockIdx.x * 4 + (tidx() >> 6), nw = gridDim.x * 4;
    const float qg = p.in[7][l * 64 + lane], kg = p.in[8][l * 64 + lane];
    const float freq = exp2f(-(float)(lane & 15) * (13.287712379549449f / 16.0f));
    for (int row = gw; row < T; row += nw) {
        const bool isx = row < TX;
        const bool doq = isx || l == 0;
        int b, key, t = 0;
        if (isx) { b = row >> 12; t = row & 4095; key = CL + t; } else { const int rc = row - TX; b = rc >> 8; key = rc & 255; }
        bf16_t* pr = P + (size_t)row * NP + lane;
        bf16_t raw[12];
#pragma unroll
        for (int v = 0; v < 12; ++v) raw[v] = (v < 8 && !doq) ? (bf16_t)0 : pr[v * 64];
        float cs = 1.f, sn = 0.f;
        if (isx) { const float rev = ((lane < 32) ? (float)(t >> 6) : (float)(t & 63)) * (freq * 0.15915494309189535f); cs = __builtin_amdgcn_cosf(rev); sn = __builtin_amdgcn_sinf(rev); }
#pragma unroll
        for (int v = 0; v < 12; ++v) {
            if (v >= 10) { VT[((size_t)(b * 2 + (v - 10)) * 64 + lane) * NKEY + key] = raw[v]; continue; }
            if (v < 8 && !doq) continue;
            const float val = bf2f(raw[v]);
            const float ss = wave_sum(val * val);
            float nv = val * rsqrtf(ss * (1.0f / 64.0f) + 1e-6f) * (v < 8 ? qg : kg);
            if (isx) {
                const float partner = __shfl_xor(nv, 16);
                nv = ((lane >> 4) & 1) ? (partner * sn + nv * cs) : (nv * cs - partner * sn);
            }
            if (v < 8) pr[v * 64] = f2bf(nv * (0.125f * 1.4426950408889634f));
            else KB[((size_t)(b * 2 + (v - 8)) * NKEY + key) * 64 + lane] = f2bf(nv);
        }
    }
}

__device__ __forceinline__ void attn_tile_compute(const bf16_t* Ks, const bf16_t* Vs, const bf16_t* Qw, f32x4 (&o)[4][2], float negmb, float (&lrun)[2], int lr, int g) {
    f32x4 st[4][2];
#pragma unroll
    for (int ki = 0; ki < 4; ++ki) { st[ki][0] = (f32x4){negmb, negmb, negmb, negmb}; st[ki][1] = (f32x4){negmb, negmb, negmb, negmb}; }
#pragma unroll
    for (int ks = 0; ks < 2; ++ks) {
        const bf16x8 q0 = *(const bf16x8*)(Qw + lr * 72 + ks * 32 + g * 8), q1 = *(const bf16x8*)(Qw + (16 + lr) * 72 + ks * 32 + g * 8);
#pragma unroll
        for (int ki = 0; ki < 4; ++ki) {
            const bf16x8 kf = *(const bf16x8*)(Ks + (ki * 16 + lr) * 72 + ks * 32 + g * 8);
            st[ki][0] = __builtin_amdgcn_mfma_f32_16x16x32_bf16(kf, q0, st[ki][0], 0, 0, 0);
            st[ki][1] = __builtin_amdgcn_mfma_f32_16x16x32_bf16(kf, q1, st[ki][1], 0, 0, 0);
        }
    }
    bf16x8 pf[2][2];
#pragma unroll
    for (int mi = 0; mi < 2; ++mi) {
        float ps = 0.f;
#pragma unroll
        for (int ki = 0; ki < 4; ++ki)
#pragma unroll
            for (int j = 0; j < 4; ++j) { const float e = __builtin_amdgcn_exp2f(st[ki][mi][j]); st[ki][mi][j] = e; ps += e; }
        lrun[mi] += ps;
#pragma unroll
        for (int kb = 0; kb < 2; ++kb) {
            union { bf16x8 v; unsigned w[4]; } pk;
            pk.w[0] = pack2(st[2 * kb][mi][0], st[2 * kb][mi][1]); pk.w[1] = pack2(st[2 * kb][mi][2], st[2 * kb][mi][3]);
            pk.w[2] = pack2(st[2 * kb + 1][mi][0], st[2 * kb + 1][mi][1]); pk.w[3] = pack2(st[2 * kb + 1][mi][2], st[2 * kb + 1][mi][3]);
            pf[mi][kb] = pk.v;
        }
    }
#pragma unroll
    for (int di = 0; di < 4; ++di)
#pragma unroll
        for (int kb = 0; kb < 2; ++kb) {
            union { bf16x8 v; uint4 q; } vf;
            vf.q = *(const uint4*)(Vs + (di * 16 + lr) * 72 + kb * 32 + g * 8);
            o[di][0] = __builtin_amdgcn_mfma_f32_16x16x32_bf16(vf.v, pf[0][kb], o[di][0], 0, 0, 0);
            o[di][1] = __builtin_amdgcn_mfma_f32_16x16x32_bf16(vf.v, pf[1][kb], o[di][1], 0, 0, 0);
        }
}

__device__ __forceinline__ void attn_tile_compute2(const bf16_t* Ks, const bf16_t* Vs, const bf16_t* Qw, f32x4 (&o)[4][2], f32x4 (&o2)[4][2], float negmb, float (&lrun)[2], float (&lrun2)[2], int lr, int g) {
    f32x4 st[4][2], st2[4][2];
#pragma unroll
    for (int ki = 0; ki < 4; ++ki) { st[ki][0] = (f32x4){negmb, negmb, negmb, negmb}; st[ki][1] = st[ki][0]; st2[ki][0] = st[ki][0]; st2[ki][1] = st[ki][0]; }
#pragma unroll
    for (int ks = 0; ks < 2; ++ks) {
        const bf16x8 q0 = *(const bf16x8*)(Qw + lr * 72 + ks * 32 + g * 8), q1 = *(const bf16x8*)(Qw + (16 + lr) * 72 + ks * 32 + g * 8);
        const bf16x8 q2 = *(const bf16x8*)(Qw + (32 + lr) * 72 + ks * 32 + g * 8), q3 = *(const bf16x8*)(Qw + (48 + lr) * 72 + ks * 32 + g * 8);
#pragma unroll
        for (int ki = 0; ki < 4; ++ki) {
            const bf16x8 kf = *(const bf16x8*)(Ks + (ki * 16 + lr) * 72 + ks * 32 + g * 8);
            st[ki][0] = __builtin_amdgcn_mfma_f32_16x16x32_bf16(kf, q0, st[ki][0], 0, 0, 0);
            st[ki][1] = __builtin_amdgcn_mfma_f32_16x16x32_bf16(kf, q1, st[ki][1], 0, 0, 0);
            st2[ki][0] = __builtin_amdgcn_mfma_f32_16x16x32_bf16(kf, q2, st2[ki][0], 0, 0, 0);
            st2[ki][1] = __builtin_amdgcn_mfma_f32_16x16x32_bf16(kf, q3, st2[ki][1], 0, 0, 0);
        }
    }
    bf16x8 pf[2][2], pf2[2][2];
#pragma unroll
    for (int mi = 0; mi < 2; ++mi) {
        float ps = 0.f, ps2 = 0.f;
#pragma unroll
        for (int ki = 0; ki < 4; ++ki)
#pragma unroll
            for (int j = 0; j < 4; ++j) {
                const float e = __builtin_amdgcn_exp2f(st[ki][mi][j]); st[ki][mi][j] = e; ps += e;
                const float e2 = __builtin_amdgcn_exp2f(st2[ki][mi][j]); st2[ki][mi][j] = e2; ps2 += e2;
            }
        lrun[mi] += ps; lrun2[mi] += ps2;
#pragma unroll
        for (int kb = 0; kb < 2; ++kb) {
            union { bf16x8 v; unsigned w[4]; } pk, pk2;
            pk.w[0] = pack2(st[2 * kb][mi][0], st[2 * kb][mi][1]); pk.w[1] = pack2(st[2 * kb][mi][2], st[2 * kb][mi][3]);
            pk.w[2] = pack2(st[2 * kb + 1][mi][0], st[2 * kb + 1][mi][1]); pk.w[3] = pack2(st[2 * kb + 1][mi][2], st[2 * kb + 1][mi][3]);
            pk2.w[0] = pack2(st2[2 * kb][mi][0], st2[2 * kb][mi][1]); pk2.w[1] = pack2(st2[2 * kb][mi][2], st2[2 * kb][mi][3]);
            pk2.w[2] = pack2(st2[2 * kb + 1][mi][0], st2[2 * kb + 1][mi][1]); pk2.w[3] = pack2(st2[2 * kb + 1][mi][2], st2[2 * kb + 1][mi][3]);
            pf[mi][kb] = pk.v; pf2[mi][kb] = pk2.v;
        }
    }
#pragma unroll
    for (int di = 0; di < 4; ++di)
#pragma unroll
        for (int kb = 0; kb < 2; ++kb) {
            union { bf16x8 v; uint4 q; } vf;
            vf.q = *(const uint4*)(Vs + (di * 16 + lr) * 72 + kb * 32 + g * 8);
            o[di][0] = __builtin_amdgcn_mfma_f32_16x16x32_bf16(vf.v, pf[0][kb], o[di][0], 0, 0, 0);
            o[di][1] = __builtin_amdgcn_mfma_f32_16x16x32_bf16(vf.v, pf[1][kb], o[di][1], 0, 0, 0);
            o2[di][0] = __builtin_amdgcn_mfma_f32_16x16x32_bf16(vf.v, pf2[0][kb], o2[di][0], 0, 0, 0);
            o2[di][1] = __builtin_amdgcn_mfma_f32_16x16x32_bf16(vf.v, pf2[1][kb], o2[di][1], 0, 0, 0);
        }
}

__device__ __forceinline__ void attn_unit(const Params& p, int l, int u, unsigned char* lds) {
    bf16_t* P = (bf16_t*)(p.ws + OFF_P);
    const bf16_t* KB = (const bf16_t*)(p.ws + OFF_KB); const bf16_t* VT = (const bf16_t*)(p.ws + OFF_VT);
    bf16_t* Ks = (bf16_t*)lds; bf16_t* Vs = Ks + 64 * 72;
    bf16_t* Qs = Vs + 64 * 72;
    const int tid = tidx(), lane = tid & 63, wid = tid >> 6, lr = lane & 15, g = lane >> 4;
    int b, kvh, row0, nkeys;
    if (u < 1024) { b = u >> 7; kvh = (u >> 6) & 1; row0 = b * SEQ + (u & 63) * 64; nkeys = NKEY; }
    else { const int i = u - 1024; b = i >> 3; kvh = (i >> 2) & 1; row0 = TX + b * CL + (i & 3) * 64; nkeys = CL; }
    const int head = kvh * 4 + wid;
    bf16_t* Qw = Qs + wid * (64 * 72);
    __syncthreads();
#pragma unroll
    for (int k = 0; k < 8; ++k) {
        const int c = lane + 64 * k, r = c >> 3, c8 = (c & 7) * 8;
        *(uint4*)(Qw + r * 72 + c8) = *(const uint4*)(P + (size_t)(row0 + r) * NP + head * 64 + c8);
    }
    f32x4 o[4][2], o2[4][2];
#pragma unroll
    for (int di = 0; di < 4; ++di) { o[di][0] = (f32x4){0.f, 0.f, 0.f, 0.f}; o[di][1] = o[di][0]; o2[di][0] = o[di][0]; o2[di][1] = o[di][0]; }
    float lrun[2] = {0.f, 0.f}, lrun2[2] = {0.f, 0.f};
    float negmb;
    {
        float mq = fabsf(p.in[7][l * 64 + lane]), mk = fabsf(p.in[8][l * 64 + lane]);
#pragma unroll
        for (int o_ = 32; o_; o_ >>= 1) { mq = fmaxf(mq, __shfl_xor(mq, o_)); mk = fmaxf(mk, __shfl_xor(mk, o_)); }
        negmb = -(8.0f * 1.4426950408889634f * 1.03f) * mq * mk;
    }
    const bf16_t* kbase = KB + (size_t)(b * 2 + kvh) * NKEY * 64;
    const bf16_t* vbase = VT + (size_t)(b * 2 + kvh) * 64 * NKEY;
    const int c0 = tid, c1 = tid + 256;
    uint4 rk0, rk1, rv0, rv1;
#define ATT_LOAD(kt) do { \
        rk0 = *(const uint4*)(kbase + (size_t)(kt) * 4096 + c0 * 8); rk1 = *(const uint4*)(kbase + (size_t)(kt) * 4096 + c1 * 8); \
        rv0 = *(const uint4*)(vbase + (size_t)(c0 >> 3) * NKEY + (kt) * 64 + (c0 & 7) * 8); \
        rv1 = *(const uint4*)(vbase + (size_t)(c1 >> 3) * NKEY + (kt) * 64 + (c1 & 7) * 8); } while (0)
    const int nkt = nkeys >> 6;
    ATT_LOAD(0);
#pragma unroll 1
    for (int kt = 0; kt < nkt; ++kt) {
        __syncthreads();
        *(uint4*)(Ks + (c0 >> 3) * 72 + (c0 & 7) * 8) = rk0; *(uint4*)(Ks + (c1 >> 3) * 72 + (c1 & 7) * 8) = rk1;
        {
            bf16_t* v0 = Vs + (c0 >> 3) * 72 + ((c0 & 7) >> 2) * 32 + 16 * (c0 & 1) + 4 * ((c0 >> 1) & 1);
            bf16_t* v1 = Vs + (c1 >> 3) * 72 + ((c1 & 7) >> 2) * 32 + 16 * (c1 & 1) + 4 * ((c1 >> 1) & 1);
            *(uint2*)v0 = make_uint2(rv0.x, rv0.y); *(uint2*)(v0 + 8) = make_uint2(rv0.z, rv0.w);
            *(uint2*)v1 = make_uint2(rv1.x, rv1.y); *(uint2*)(v1 + 8) = make_uint2(rv1.z, rv1.w);
        }
        __syncthreads();
        if (kt + 1 < nkt) ATT_LOAD(kt + 1);
        attn_tile_compute2(Ks, Vs, Qw, o, o2, negmb, lrun, lrun2, lr, g);
    }
#undef ATT_LOAD
#pragma unroll
    for (int mi = 0; mi < 2; ++mi) {
        float lsum = lrun[mi]; lsum += __shfl_xor(lsum, 16); lsum += __shfl_xor(lsum, 32);
        float lsum2 = lrun2[mi]; lsum2 += __shfl_xor(lsum2, 16); lsum2 += __shfl_xor(lsum2, 32);
        const float inv = 1.0f / lsum, inv2 = 1.0f / lsum2;
#pragma unroll
        for (int di = 0; di < 4; ++di) {
            uint2 w; w.x = pack2(o[di][mi][0] * inv, o[di][mi][1] * inv); w.y = pack2(o[di][mi][2] * inv, o[di][mi][3] * inv);
            *(uint2*)(P + (size_t)(row0 + mi * 16 + lr) * NP + head * 64 + di * 16 + g * 4) = w;
            w.x = pack2(o2[di][mi][0] * inv2, o2[di][mi][1] * inv2); w.y = pack2(o2[di][mi][2] * inv2, o2[di][mi][3] * inv2);
            *(uint2*)(P + (size_t)(row0 + 32 + mi * 16 + lr) * NP + head * 64 + di * 16 + g * 4) = w;
        }
    }
    __syncthreads();
}

constexpr int RCH = 272;
template <int MODE>
__device__ __forceinline__ void rwkv_chunk_unit(const Params& p, int l, int u, unsigned char* lds) {
    const bf16_t* P = (const bf16_t*)(p.ws + OFF_P); bf16_t* YRW = (bf16_t*)(p.ws + OFF_YRW);
    float* RWE = (float*)(p.ws + OFF_RWE); const float* RWS0 = (const float*)(p.ws + OFF_RWS0);
    const int chain = u >> 3, cp = u & 7, b = chain >> 3, d = (chain >> 2) & 1, h = chain & 3;
    bf16_t* W2T = (bf16_t*)lds; bf16_t* A2T = W2T + 64 * 72;
    bf16_t* tw16 = A2T + 64 * 72; bf16_t* a116 = tw16 + 16 * 72;
    float* tw = (float*)(a116 + 16 * 72);
    float* a1s = tw + 1024; float* kks = a1s + 1024; float* rrs = kks + 1024; float* vvs = rrs + 1024;
    float* dec = vvs + 1024; float* kdr = dec + 1024; float* bbs = kdr + 1024;
    bf16_t* raw = (bf16_t*)dec;
    const int tid = tidx(), lane = tid & 63, wid = tid >> 6;
    const float* w2 = p.in[19] + (size_t)(l * 2 + d) * 64 * 256 + h * 64;
    const float* a2 = p.in[21] + (size_t)(l * 2 + d) * 64 * 256 + h * 64;
    __syncthreads();
    for (int i = tid; i < 2048; i += NTHR) {
        const int r2 = (i >> 6) * 2, j = i & 63;
        *(unsigned*)(W2T + j * 72 + r2) = pack2(w2[r2 * 256 + j], w2[(r2 + 1) * 256 + j]);
        *(unsigned*)(A2T + j * 72 + r2) = pack2(a2[r2 * 256 + j], a2[(r2 + 1) * 256 + j]);
    }
    const float* mu0 = p.in[17] + (size_t)l * 2 * 1152; const float* mu1 = mu0 + 1152;
    const float* w0 = p.in[18] + (l * 2 + d) * 256 + h * 64; const float* a0 = p.in[20] + (l * 2 + d) * 256 + h * 64;
    const float* k_k = p.in[23] + l * 256 + h * 64; const float* k_a = p.in[24] + l * 256 + h * 64;
    constexpr bool scan_wave = true;
    const int sel = wid >> 1;
    const bool isE = MODE == 0 && !(wid & 1);
    const int chunk = 2 * cp + sel;
    constexpr int NV = MODE == 0 ? 4 : 2;
    const int vb = MODE == 0 ? 0 : 2 * (wid & 1);
    const int vq = lane & 15, g = lane >> 4;
    const int lr = vq;
    f32x4 Zt[4][4];
#pragma unroll
    for (int kt = 0; kt < 4; ++kt)
#pragma unroll
        for (int vt = 0; vt < 4; ++vt)
#pragma unroll
            for (int j = 0; j < 4; ++j) Zt[kt][vt][j] = (isE && (16 * kt + 4 * g + j) == (16 * vt + lr)) ? 1.f : 0.f;
    bf16_t* ops = (bf16_t*)((unsigned char*)lds + 56320) + sel * 3968;
    bf16_t* Ar = ops; bf16_t* Br = ops + 576; bf16_t* Kr = ops + 1152; bf16_t* Rr = ops + 1728;
    bf16_t* NBt = ops + 2304; bf16_t* Kt = ops + 2816; bf16_t* Vt = ops + 3328;
    const float* gL = (const float*)(ops + 3840);
    float mum0[3], mum1[3];
#pragma unroll
    for (int i = 0; i < 3; ++i) {
        const int c = tid + i * NTHR, rem = c % 320, vec = rem >> 6, j = rem & 63;
        const int col = vec < 3 ? vec * 256 + h * 64 + j : (vec == 3 ? 768 : 896) + d * 64 + j;
        mum0[i] = c < 640 ? mu0[col] : 0.f; mum1[i] = c < 640 ? mu1[col] : 0.f;
    }
    uint4 pre0, pre1, pre2, pre3;
    int sgp[4], sgc[4], sgl[4];
#pragma unroll
    for (int I = 0; I < 4; ++I) {
        const int q = tid + I * NTHR, slot = q / 400, rem = q % 400, rr = rem / 40, seg = (rem % 40) >> 3, part = rem & 7;
        sgp[I] = (2 * cp + slot) * RCH;
        sgc[I] = (rr << 16) | (RWO + (seg < 3 ? seg * 256 + h * 64 : (seg == 3 ? 768 : 896) + d * 64) + part * 8);
        sgl[I] = q < 800 ? (slot * 10 + rr) * 320 + seg * 64 + part * 8 : -1;
    }
#define RW_ISSUE(I, SUB) do { pre##I = make_uint4(0u, 0u, 0u, 0u); \
        if (sgl[I] >= 0) { int row, t, n; scan_pos(b, d, sgp[I] + (SUB) * 8, row, t, n); \
            const int tlo = d ? t - 7 : t, tt = tlo - 1 + (sgc[I] >> 16); \
            if (tt >= 0 && tt < n) pre##I = *(const uint4*)(P + (size_t)(row - t + tt) * NP + (sgc[I] & 0xffff)); } } while (0)
#define RW_STORE(I) do { if (sgl[I] >= 0) *(uint4*)(raw + sgl[I]) = pre##I; } while (0)
    RW_ISSUE(0, 0); RW_ISSUE(1, 0); RW_ISSUE(2, 0); RW_ISSUE(3, 0);
#pragma unroll 1
    for (int sub = 0; sub < RCH / 8; ++sub) {
        __syncthreads();
        RW_STORE(0); RW_STORE(1); RW_STORE(2); RW_STORE(3);
        if (sub + 1 < RCH / 8) { RW_ISSUE(0, sub + 1); RW_ISSUE(1, sub + 1); RW_ISSUE(2, sub + 1); RW_ISSUE(3, sub + 1); }
        __syncthreads();
        for (int c = tid; c < 640; c += NTHR) {
            const int slot = c >= 320 ? 1 : 0, rem = c - slot * 320, vec = rem >> 6, j = rem & 63;
            const int col = vec < 3 ? vec * 256 + h * 64 + j : (vec == 3 ? 768 : 896) + d * 64 + j;
            const float m0 = c < 256 ? mum0[0] : (c < 512 ? mum0[1] : mum0[2]), m1 = c < 256 ? mum1[0] : (c < 512 ? mum1[1] : mum1[2]);
            const bf16_t* pr = raw + slot * 3200 + rem;
            float* dstp = (vec == 0 ? rrs : vec == 1 ? kks : vvs) + slot * 512 + j;
            bf16_t* dst16 = (vec == 3 ? tw16 : a116) + slot * (8 * 72) + j;
            float prev = bf2f(pr[0]), cur = bf2f(pr[320]);
#pragma unroll
            for (int i = 0; i < 8; ++i) {
                const float nxt = bf2f(pr[(i + 2) * 320]);
                float sm = cur + (prev - cur) * m0 + (nxt - cur) * m1;
                if (vec == 3) sm = tanh_fast(sm);
                if (vec < 3) dstp[(d ? 7 - i : i) * 64] = sm; else dst16[(d ? 7 - i : i) * 72] = f2bf(sm);
                prev = cur; cur = nxt;
            }
        }
        __syncthreads();
        {
            const int lr_ = lane & 15, g_ = lane >> 4;
            f32x4 dw = {0.f, 0.f, 0.f, 0.f}, da = {0.f, 0.f, 0.f, 0.f};
#pragma unroll
            for (int ks = 0; ks < 2; ++ks) {
                const bf16x8 xt = *(const bf16x8*)(tw16 + lr_ * 72 + ks * 32 + g_ * 8), xa = *(const bf16x8*)(a116 + lr_ * 72 + ks * 32 + g_ * 8);
                const bf16x8 wb = *(const bf16x8*)(W2T + (wid * 16 + lr_) * 72 + ks * 32 + g_ * 8), ab = *(const bf16x8*)(A2T + (wid * 16 + lr_) * 72 + ks * 32 + g_ * 8);
                dw = __builtin_amdgcn_mfma_f32_16x16x32_bf16(xt, wb, dw, 0, 0, 0);
                da = __builtin_amdgcn_mfma_f32_16x16x32_bf16(xa, ab, da, 0, 0, 0);
            }
#pragma unroll
            for (int j = 0; j < 4; ++j) { tw[(4 * g_ + j) * 64 + wid * 16 + lr_] = dw[j]; a1s[(4 * g_ + j) * 64 + wid * 16 + lr_] = da[j]; }
        }
        __syncthreads();
        {
            const int ts = tid >> 4, j0 = (tid & 15) * 4;
            const f32x4 wv = *(const f32x4*)(w0 + j0) + *(const f32x4*)(tw + ts * 64 + j0), av = *(const f32x4*)(a0 + j0) + *(const f32x4*)(a1s + ts * 64 + j0);
            const f32x4 kraw = *(const f32x4*)(kks + ts * 64 + j0), kkw = *(const f32x4*)(k_k + j0), kaw = *(const f32x4*)(k_a + j0);
            f32x4 kkv = kraw * kkw;
            float ss = kkv[0] * kkv[0] + kkv[1] * kkv[1] + kkv[2] * kkv[2] + kkv[3] * kkv[3];
#pragma unroll
            for (int o = 8; o; o >>= 1) ss += __shfl_xor(ss, o);
            const float rn = rsqrtf(ss + 1e-12f);
            f32x4 dcv, kdv, bbv;
#pragma unroll
            for (int q = 0; q < 4; ++q) {
                dcv[q] = __expf(-0.6065306597126334f * __builtin_amdgcn_rcpf(1.0f + __expf(-wv[q])));
                const float aa = sigmoidf_(av[q]);
                kdv[q] = kraw[q] * (1.f + (aa - 1.f) * kaw[q]);
                kkv[q] = kkv[q] * rn;
                bbv[q] = kkv[q] * aa;
            }
            *(f32x4*)(dec + ts * 64 + j0) = dcv; *(f32x4*)(kdr + ts * 64 + j0) = kdv; *(f32x4*)(kks + ts * 64 + j0) = kkv; *(f32x4*)(bbs + ts * 64 + j0) = bbv;
        }
        __syncthreads();
        {
            const int sl = tid >> 7, hf = (tid >> 6) & 1, k = tid & 63;
            bf16_t* ob = (bf16_t*)((unsigned char*)lds + 56320) + sl * 3968;
            if (hf == 0) {
                float gm = 1.f;
                union { uint4 q; bf16_t hh[8]; } nb, k8;
#pragma unroll
                for (int t = 0; t < 8; ++t) {
                    const int ts = sl * 8 + t;
                    const float gp = gm; gm *= dec[ts * 64 + k];
                    const float ig = __builtin_amdgcn_rcpf(gm);
                    const float be = bbs[ts * 64 + k] * ig, ka = kdr[ts * 64 + k] * ig;
                    ob[t * 72 + k] = f2bf(gp * kks[ts * 64 + k]); ob[576 + t * 72 + k] = f2bf(be); ob[1152 + t * 72 + k] = f2bf(ka); ob[1728 + t * 72 + k] = f2bf(gm * rrs[ts * 64 + k]);
                    nb.hh[t] = f2bf(-be); k8.hh[t] = f2bf(ka);
                }
                *(uint4*)(ob + 2304 + k * 8) = nb.q; *(uint4*)(ob + 2816 + k * 8) = k8.q;
                ((float*)(ob + 3840))[k] = gm;
            } else {
                union { uint4 q; bf16_t hh[8]; } v8;
#pragma unroll
                for (int t = 0; t < 8; ++t) v8.hh[t] = f2bf(vvs[(sl * 8 + t) * 64 + k]);
                *(uint4*)(ob + 3328 + k * 8) = v8.q;
            }
        }
        __syncthreads();
        {
#define RW_PK4(a) ({ union { s16x4 v; unsigned w[2]; } u_; u_.w[0] = pack2((a)[0], (a)[1]); u_.w[1] = pack2((a)[2], (a)[3]); u_.v; })
#define RW_MF16(A, B, C) __builtin_amdgcn_mfma_f32_16x16x16bf16_1k(A, B, C, 0, 0, 0)
#define RW_MF32(A, B, C) __builtin_amdgcn_mfma_f32_16x16x32_bf16(A, B, C, 0, 0, 0)
            const int lrc = lr & 7;
            const bool tv = lr < 8, gv2 = g < 2;
            const f32x4 z4 = {0.f, 0.f, 0.f, 0.f};
            f32x4 Nn = z4, NT = z4, MH1 = z4, G2 = z4, H2 = z4;
#pragma unroll
            for (int ks = 0; ks < 2; ++ks) {
                union { bf16x8 v; uint4 q; } fa, fb, fk, fr;
                fa.q = *(const uint4*)(Ar + lrc * 72 + ks * 32 + g * 8); fb.q = *(const uint4*)(Br + lrc * 72 + ks * 32 + g * 8);
                fr.q = *(const uint4*)(Rr + lrc * 72 + ks * 32 + g * 8);
                if (!tv) { fa.q = make_uint4(0u, 0u, 0u, 0u); fb.q = fa.q; fr.q = fa.q; }
                Nn = RW_MF32(fb.v, fa.v, Nn);
                NT = RW_MF32(fa.v, fb.v, NT);
                MH1 = RW_MF32(fb.v, fr.v, MH1);
                if (!isE) {
                    fk.q = *(const uint4*)(Kr + lrc * 72 + ks * 32 + g * 8);
                    if (!tv) fk.q = make_uint4(0u, 0u, 0u, 0u);
                    G2 = RW_MF32(fk.v, fa.v, G2);
                    H2 = RW_MF32(fk.v, fr.v, H2);
                }
            }
#pragma unroll
            for (int j = 0; j < 4; ++j) {
                const int i_ = 4 * g + j;
                Nn[j] = i_ < lr ? -Nn[j] : 0.f;
                NT[j] = lr < i_ ? -NT[j] : 0.f;
                MH1[j] = i_ <= lr ? -MH1[j] : 0.f;
                G2[j] = i_ < lr ? G2[j] : 0.f;
                H2[j] = i_ <= lr ? H2[j] : 0.f;
            }
            const s16x4 pN = RW_PK4(Nn), pNT = RW_PK4(NT);
            const f32x4 N2 = RW_MF16(pNT, pN, z4), N2T = RW_MF16(pN, pNT, z4);
            const s16x4 pN2 = RW_PK4(N2), pN2T = RW_PK4(N2T);
            const f32x4 N4 = RW_MF16(pN2T, pN2, z4);
            const s16x4 pN4 = RW_PK4(N4), pMH1 = RW_PK4(MH1), pG2 = RW_PK4(G2), pH2 = RW_PK4(H2);
            bf16x8 aP[2], rP[2];
#pragma unroll
            for (int m = 0; m < 2; ++m) {
                union { bf16x8 v; uint2 hq[2]; } ua, ur;
                ua.hq[0] = *(const uint2*)(Ar + lrc * 72 + 32 * m + 4 * g); ua.hq[1] = *(const uint2*)(Ar + lrc * 72 + 32 * m + 16 + 4 * g);
                ur.hq[0] = *(const uint2*)(Rr + lrc * 72 + 32 * m + 4 * g); ur.hq[1] = *(const uint2*)(Rr + lrc * 72 + 32 * m + 16 + 4 * g);
                if (!tv) { ua.hq[0] = make_uint2(0u, 0u); ua.hq[1] = ua.hq[0]; ur.hq[0] = ua.hq[0]; ur.hq[1] = ua.hq[0]; }
                aP[m] = ua.v; rP[m] = ur.v;
            }
            int orow[4];
#pragma unroll
            for (int j = 0; j < 4; ++j) { int t_, n_; scan_pos(b, d, chunk * RCH + sub * 8 + ((4 * g + j) & 7), orow[j], t_, n_); }
            s16x4 pCT[4];
#pragma unroll
            for (int vt = 0; vt < 4; ++vt) {
                bf16x8 zb[2];
#pragma unroll
                for (int m = 0; m < 2; ++m) {
                    union { bf16x8 v; unsigned w[4]; } uz;
                    uz.w[0] = pack2(Zt[2 * m][vt][0], Zt[2 * m][vt][1]); uz.w[1] = pack2(Zt[2 * m][vt][2], Zt[2 * m][vt][3]);
                    uz.w[2] = pack2(Zt[2 * m + 1][vt][0], Zt[2 * m + 1][vt][1]); uz.w[3] = pack2(Zt[2 * m + 1][vt][2], Zt[2 * m + 1][vt][3]);
                    zb[m] = uz.v;
                }
                union { s16x4 v; uint2 q; } vf; vf.q = make_uint2(0u, 0u);
                if (!isE) { vf.q = *(const uint2*)(Vt + (16 * vt + lr) * 8 + 4 * (g & 1)); if (!gv2) vf.q = make_uint2(0u, 0u); }
                f32x4 c = RW_MF32(aP[0], zb[0], z4); c = RW_MF32(aP[1], zb[1], c);
                f32x4 y = RW_MF32(rP[0], zb[0], z4); y = RW_MF32(rP[1], zb[1], y);
                if (!isE) { c = RW_MF16(pG2, vf.v, c); y = RW_MF16(pH2, vf.v, y); }
                c = RW_MF16(pN, RW_PK4(c), c);
                c = RW_MF16(pN2, RW_PK4(c), c);
                c = RW_MF16(pN4, RW_PK4(c), c);
                pCT[vt] = RW_PK4(c);
                y = RW_MF16(pMH1, pCT[vt], y);
                if (gv2) {
                    bf16_t* ob = isE ? (bf16_t*)(p.ws + OFF_P) + 1024 + d * 256 + h * 64 + 16 * vt + lr : YRW + (size_t)d * T * 256 + h * 64 + 16 * vt + lr;
                    const size_t rs = isE ? (size_t)NP : (size_t)256;
#pragma unroll
                    for (int j = 0; j < 4; ++j) ob[(size_t)orow[j] * rs] = f2bf(y[j]);
                }
            }
#pragma unroll
            for (int kt = 0; kt < 4; ++kt) {
                union { s16x4 v; uint2 q; } nbf, ktf;
                nbf.q = *(const uint2*)(NBt + (16 * kt + lr) * 8 + 4 * (g & 1)); ktf.q = make_uint2(0u, 0u);
                if (!isE) ktf.q = *(const uint2*)(Kt + (16 * kt + lr) * 8 + 4 * (g & 1));
                if (!gv2) { nbf.q = make_uint2(0u, 0u); ktf.q = nbf.q; }
                const f32x4 gl = *(const f32x4*)(gL + 16 * kt + 4 * g);
#pragma unroll
                for (int vt = 0; vt < 4; ++vt) {
                    f32x4 z = RW_MF16(nbf.v, pCT[vt], Zt[kt][vt]);
                    if (!isE) {
                        union { s16x4 v; uint2 q; } vf; vf.q = *(const uint2*)(Vt + (16 * vt + lr) * 8 + 4 * (g & 1)); if (!gv2) vf.q = make_uint2(0u, 0u);
                        z = RW_MF16(ktf.v, vf.v, z);
                    }
                    Zt[kt][vt] = z * gl;
                }
            }
#undef RW_PK4
#undef RW_MF16
#undef RW_MF32
        }
    }
    if (MODE == 0) {
        float* dst = RWE + ((size_t)(chain * 16 + chunk) * 2 + (isE ? 0 : 1)) * 4096;
#pragma unroll
        for (int vt = 0; vt < 4; ++vt)
#pragma unroll
            for (int kt = 0; kt < 4; ++kt) *(f32x4*)(dst + (16 * vt + lr) * 64 + 16 * kt + 4 * g) = Zt[kt][vt];
    }
    __syncthreads();
}

#undef RW_ISSUE
#undef RW_STORE
__device__ __forceinline__ void rwkv_passC_unit(const Params& p, int u, unsigned char* lds) {
    (void)lds;
    const bf16_t* P = (const bf16_t*)(p.ws + OFF_P); bf16_t* YRW = (bf16_t*)(p.ws + OFF_YRW); const float* RWS0 = (const float*)(p.ws + OFF_RWS0);
    const int chain = u >> 3, cp = u & 7, b = chain >> 3, d = (chain >> 2) & 1, h = chain & 3;
    const int tid = tidx(), lane = tid & 63, wid = tid >> 6, lr = lane & 15, g = lane >> 4;
#pragma unroll 1
    for (int cs = 0; cs < 2; ++cs) {
        const int chunk = 2 * cp + cs;
        const float* s0 = RWS0 + (size_t)(chain * 16 + chunk) * 4096;
        bf16x8 sb[4][2];
#pragma unroll
        for (int vt = 0; vt < 4; ++vt)
#pragma unroll
            for (int ks = 0; ks < 2; ++ks) {
                const float* sp = s0 + (vt * 16 + lr) * 64 + ks * 32 + g * 8;
                const f32x4 lo = *(const f32x4*)sp, hi = *(const f32x4*)(sp + 4);
                union { bf16x8 v; unsigned w[4]; } pk;
                pk.w[0] = pack2(lo[0], lo[1]); pk.w[1] = pack2(lo[2], lo[3]); pk.w[2] = pack2(hi[0], hi[1]); pk.w[3] = pack2(hi[2], hi[3]);
                sb[vt][ks] = pk.v;
            }
#pragma unroll 1
        for (int tile = wid; tile < RCH / 16; tile += 4) {
            const int pos0 = chunk * RCH + tile * 16;
            int rowA, tA, nA; scan_pos(b, d, pos0 + lr, rowA, tA, nA);
            const bf16_t* qp = P + (size_t)rowA * NP + 1024 + d * 256 + h * 64 + g * 8;
            const bf16x8 q0 = *(const bf16x8*)qp, q1 = *(const bf16x8*)(qp + 32);
            int rows[4];
#pragma unroll
            for (int j = 0; j < 4; ++j) { int t_, n_; scan_pos(b, d, pos0 + 4 * g + j, rows[j], t_, n_); }
#pragma unroll
            for (int vt = 0; vt < 4; ++vt) {
                f32x4 acc = {0.f, 0.f, 0.f, 0.f};
                acc = __builtin_amdgcn_mfma_f32_16x16x32_bf16(q0, sb[vt][0], acc, 0, 0, 0);
                acc = __builtin_amdgcn_mfma_f32_16x16x32_bf16(q1, sb[vt][1], acc, 0, 0, 0);
#pragma unroll
                for (int j = 0; j < 4; ++j) {
                    bf16_t* yp = YRW + ((size_t)d * T + rows[j]) * 256 + h * 64 + vt * 16 + lr;
                    *yp = f2bf(bf2f(*yp) + acc[j]);
                }
            }
        }
    }
}

__device__ __forceinline__ void rwkv_passB_unit(const Params& p, int chain, unsigned char* lds) {
    const float* RWE = (const float*)(p.ws + OFF_RWE); float* RWS0 = (float*)(p.ws + OFF_RWS0);
    float* Ss = (float*)lds;
    float* EsT = Ss + 64 * 68;
    float* Ls = EsT + 64 * 68;
    const int tid = tidx(), lane = tid & 63, wid = tid >> 6, lr = lane & 15, g = lane >> 4;
    __syncthreads();
    for (int i = tid; i < 64 * 68; i += NTHR) Ss[i] = 0.f;
    f32x4 eR[4], lR[4];
    {
        const float* e0 = RWE + ((size_t)(chain * 16) * 2) * 4096;
#pragma unroll
        for (int k = 0; k < 4; ++k) { eR[k] = *(const f32x4*)(e0 + (tid + k * NTHR) * 4); lR[k] = *(const f32x4*)(e0 + 4096 + (tid + k * NTHR) * 4); }
    }
#pragma unroll 1
    for (int c = 0; c < 16; ++c) {
        __syncthreads();
#pragma unroll
        for (int k = 0; k < 4; ++k) {
            const int i4 = (tid + k * NTHR) * 4, e = i4 >> 6, k0 = i4 & 63;
            EsT[(k0 + 0) * 68 + e] = eR[k][0]; EsT[(k0 + 1) * 68 + e] = eR[k][1]; EsT[(k0 + 2) * 68 + e] = eR[k][2]; EsT[(k0 + 3) * 68 + e] = eR[k][3];
            *(f32x4*)(Ls + i4) = lR[k];
        }
        if (c + 1 < 16) {
            const float* e1 = RWE + ((size_t)(chain * 16 + c + 1) * 2) * 4096;
#pragma unroll
            for (int k = 0; k < 4; ++k) { eR[k] = *(const f32x4*)(e1 + (tid + k * NTHR) * 4); lR[k] = *(const f32x4*)(e1 + 4096 + (tid + k * NTHR) * 4); }
        }
        for (int i = tid; i < 1024; i += NTHR) *(f32x4*)(RWS0 + (size_t)(chain * 16 + c) * 4096 + i * 4) = *(const f32x4*)(Ss + (i >> 4) * 68 + (i & 15) * 4);
        __syncthreads();
        if (c == 15) break;
        bf16x8 sh[2], sl[2];
#pragma unroll
        for (int ks = 0; ks < 2; ++ks) {
            const float* sp = Ss + (16 * wid + lr) * 68 + ks * 32 + g * 8;
            const f32x4 a0 = *(const f32x4*)sp, a1 = *(const f32x4*)(sp + 4);
            union { bf16x8 v; unsigned w[4]; } uh, ul;
            uh.w[0] = pack2(a0[0], a0[1]); uh.w[1] = pack2(a0[2], a0[3]); uh.w[2] = pack2(a1[0], a1[1]); uh.w[3] = pack2(a1[2], a1[3]);
            const float r0 = a0[0] - __uint_as_float(uh.w[0] << 16), r1 = a0[1] - __uint_as_float(uh.w[0] & 0xffff0000u);
            const float r2 = a0[2] - __uint_as_float(uh.w[1] << 16), r3 = a0[3] - __uint_as_float(uh.w[1] & 0xffff0000u);
            const float r4 = a1[0] - __uint_as_float(uh.w[2] << 16), r5 = a1[1] - __uint_as_float(uh.w[2] & 0xffff0000u);
            const float r6 = a1[2] - __uint_as_float(uh.w[3] << 16), r7 = a1[3] - __uint_as_float(uh.w[3] & 0xffff0000u);
            ul.w[0] = pack2(r0, r1); ul.w[1] = pack2(r2, r3); ul.w[2] = pack2(r4, r5); ul.w[3] = pack2(r6, r7);
            sh[ks] = uh.v; sl[ks] = ul.v;
        }
        f32x4 dn[4];
#pragma unroll
        for (int kt = 0; kt < 4; ++kt) {
            f32x4 acc = *(const f32x4*)(Ls + (16 * wid + lr) * 64 + 16 * kt + 4 * g);
#pragma unroll
            for (int ks = 0; ks < 2; ++ks) {
                const float* ep = EsT + (16 * kt + lr) * 68 + ks * 32 + g * 8;
                const f32x4 e0 = *(const f32x4*)ep, e1 = *(const f32x4*)(ep + 4);
                union { bf16x8 v; unsigned w[4]; } ue;
                ue.w[0] = pack2(e0[0], e0[1]); ue.w[1] = pack2(e0[2], e0[3]); ue.w[2] = pack2(e1[0], e1[1]); ue.w[3] = pack2(e1[2], e1[3]);
                acc = __builtin_amdgcn_mfma_f32_16x16x32_bf16(ue.v, sh[ks], acc, 0, 0, 0);
                acc = __builtin_amdgcn_mfma_f32_16x16x32_bf16(ue.v, sl[ks], acc, 0, 0, 0);
            }
            dn[kt] = acc;
        }
#pragma unroll
        for (int kt = 0; kt < 4; ++kt) *(f32x4*)(Ss + (16 * wid + lr) * 68 + 16 * kt + 4 * g) = dn[kt];
    }
    __syncthreads();
}

__device__ __forceinline__ float gelu_tanh(float x) { return 0.5f * x * (1.f + tanh_fast(0.7978845608028654f * (x + 0.044715f * x * x * x))); }
template <int MODE>
__device__ __forceinline__ void lru_chunk_unit(const Params& p, int l, int u, unsigned char* lds) {
    const bf16_t* P = (const bf16_t*)(p.ws + OFF_P);
    float* LRAB = (float*)(p.ws + OFF_LRAB); const float* LRH0 = (const float*)(p.ws + OFF_LRH0);
    const int chunk = u & 15, d = (u >> 4) & 1, nb = (u >> 5) & 3, b = u >> 7;
    bf16_t* HFd = (bf16_t*)(p.ws + (d ? OFF_HF1 : OFF_HF));
    bf16_t* rawx = (bf16_t*)lds;
    bf16_t* wT = rawx + 280 * 64;
    bf16_t* xcs = wT + 2 * 64 * 72;
    float* xcf = (float*)(xcs + 2 * 16 * 72);
    const int tid = tidx(), lane = tid & 63, wid = tid >> 6, lr = lane & 15, g = lane >> 4;
    const float* cw = p.in[28] + (size_t)l * 4 * 256 + nb * 64; const float* cb = p.in[29] + l * 256 + nb * 64;
    const float* wa = p.in[30] + ((size_t)(l * 2 + d) * 4 + nb) * 4096; const float* wx = p.in[32] + ((size_t)(l * 2 + d) * 4 + nb) * 4096;
    const float* ba = p.in[31] + (l * 2 + d) * 256 + nb * 64; const float* bx = p.in[33] + (l * 2 + d) * 256 + nb * 64; const float* lam = p.in[34] + (l * 2 + d) * 256 + nb * 64;
    const int na = chunk == 0 ? 256 : RCH;
    int rowA, tA, nA, rowB = 0, tB = 0, nB = 1;
    scan_pos(b, d, chunk * RCH, rowA, tA, nA);
    if (chunk == 0) scan_pos(b, d, 256, rowB, tB, nB);
    const int tloA = d ? tA - (na - 1) : tA, tloB = d ? tB - 15 : tB;
    const int nrA = na + 3;
    __syncthreads();
    for (int i = tid; i < 2048; i += NTHR) {
        const int cq = (i >> 6) * 2, ch = i & 63;
        *(unsigned*)(wT + ch * 72 + cq) = pack2(wa[cq * 64 + ch], wa[(cq + 1) * 64 + ch]);
        *(unsigned*)(wT + (64 + ch) * 72 + cq) = pack2(wx[cq * 64 + ch], wx[(cq + 1) * 64 + ch]);
    }
    {
        const int nrows = nrA + (chunk == 0 ? 19 : 0);
        for (int q = tid; q < nrows * 8; q += NTHR) {
            const int r = q >> 3, part = q & 7;
            const bool inB = r >= nrA;
            const int tt = inB ? tloB - 1 + (r - nrA) : tloA - 1 + r;
            const int nn = inB ? nB : nA;
            const int grow = inB ? rowB - tB + tt : rowA - tA + tt;
            uint4 v = make_uint4(0u, 0u, 0u, 0u);
            if (tt >= 0 && tt < nn) v = *(const uint4*)(P + (size_t)grow * NP + LRO + 256 + nb * 64 + part * 8);
            *(uint4*)(rawx + r * 64 + part * 8) = v;
        }
    }
    const int cc = tid & 63;
    const float cw0 = cw[cc], cw1 = cw[256 + cc], cw2 = cw[512 + cc], cw3 = cw[768 + cc], cbb = cb[cc];
    const int chq = wid * 16 + lr;
    const float baq = ba[chq], bxq = bx[chq], spq = -8.0f * softplusf_(-lam[chq]);
    float hst = 0.f, aprod = 1.f;
    if (MODE == 1) hst = __hip_atomic_load(LRH0 + (size_t)u * 64 + chq, __ATOMIC_RELAXED, __HIP_MEMORY_SCOPE_AGENT);
    __syncthreads();
#define LRU_CONV(sub) do { const int p0_ = (sub) * 16; const bool inB_ = p0_ >= na; const int q0_ = inB_ ? p0_ - na : p0_; \
        const int seglen_ = inB_ ? 16 : na, rbase_ = inB_ ? nrA : 0; \
        bf16_t* xs_ = xcs + ((sub) & 1) * (16 * 72); float* xf_ = xcf + ((sub) & 1) * 1024; \
        _Pragma("unroll") for (int i = 0; i < 4; ++i) { \
            const int tok = (tid >> 6) + 4 * i, qq = q0_ + tok, off = d ? seglen_ - 1 - qq : qq; \
            const bf16_t* rp = rawx + (rbase_ + off) * 64 + cc;                  \
            const float xv = cbb + cw0 * bf2f(rp[0]) + cw1 * bf2f(rp[64]) + cw2 * bf2f(rp[128]) + cw3 * bf2f(rp[192]); \
            xf_[tok * 64 + cc] = xv; xs_[tok * 72 + cc] = f2bf(xv); } } while (0)
    LRU_CONV(0);
    __syncthreads();
#pragma unroll 1
    for (int sub = 0; sub < RCH / 16; ++sub) {
        if (sub + 1 < RCH / 16) LRU_CONV(sub + 1);
        const bf16_t* xs = xcs + (sub & 1) * (16 * 72); const float* xf = xcf + (sub & 1) * 1024;
        f32x4 ra = {0.f, 0.f, 0.f, 0.f}, ia = {0.f, 0.f, 0.f, 0.f};
#pragma unroll
        for (int ks = 0; ks < 2; ++ks) {
            const bf16x8 xa = *(const bf16x8*)(xs + lr * 72 + ks * 32 + g * 8);
            const bf16x8 wfa = *(const bf16x8*)(wT + (wid * 16 + lr) * 72 + ks * 32 + g * 8);
            const bf16x8 wfx = *(const bf16x8*)(wT + (64 + wid * 16 + lr) * 72 + ks * 32 + g * 8);
            ra = __builtin_amdgcn_mfma_f32_16x16x32_bf16(xa, wfa, ra, 0, 0, 0);
            ia = __builtin_amdgcn_mfma_f32_16x16x32_bf16(xa, wfx, ia, 0, 0, 0);
        }
        float Al[4], Hl[4];
        {
            float A = 1.f, H = 0.f;
#pragma unroll
            for (int j = 0; j < 4; ++j) {
                const float r = sigmoidf_(ra[j] + baq), ig = sigmoidf_(ia[j] + bxq);
                const float log_a = r * spq;
                const float a = __expf(log_a);
                const float x2 = 2.0f * log_a;
                const float om = x2 > -0.0625f ? -x2 * (1.f + x2 * (0.5f + x2 * (0.16666667f + x2 * 0.041666668f))) : 1.f - a * a;
                const float bb = __builtin_amdgcn_sqrtf(om) * (ig * xf[(4 * g + j) * 64 + chq]);
                H = a * H + bb; A *= a; Al[j] = A; Hl[j] = H;
            }
        }
        float A = Al[3], H = Hl[3];
        {
            float Ap = __shfl(A, lane - 16), Hp = __shfl(H, lane - 16);
            if (g >= 1) { H = A * Hp + H; A = A * Ap; }
            Ap = __shfl(A, lane - 32); Hp = __shfl(H, lane - 32);
            if (g >= 2) { H = A * Hp + H; A = A * Ap; }
        }
        float Ae = __shfl(A, lane - 16), He = __shfl(H, lane - 16);
        if (g == 0) { Ae = 1.f; He = 0.f; }
        const float hs = He + Ae * hst;
        if (MODE == 1) {
            const int p0 = sub * 16;
            const bool inB = p0 >= na;
            const int q0 = inB ? p0 - na : p0, seglen = inB ? 16 : na;
#pragma unroll
            for (int j = 0; j < 4; ++j) {
                const int qq = q0 + 4 * g + j, off = d ? seglen - 1 - qq : qq;
                const int grow = inB ? rowB - tB + tloB + off : rowA - tA + tloA + off;
                HFd[(size_t)grow * 256 + nb * 64 + chq] = f2bf(Hl[j] + Al[j] * hs);
            }
        }
        const float At = __shfl(A, 48 + lr), Ht = __shfl(H, 48 + lr);
        hst = Ht + At * hst; aprod *= At;
        __syncthreads();
    }
#undef LRU_CONV
    if (MODE == 0 && g == 0) { LRAB[(size_t)u * 128 + chq] = aprod; LRAB[(size_t)u * 128 + 64 + chq] = hst; }
    __syncthreads();
}
__device__ __forceinline__ void lru_passB_unit(const Params& p, int uc) {
    const float* LRAB = (const float*)(p.ws + OFF_LRAB); float* LRH0 = (float*)(p.ws + OFF_LRH0);
    const int tid = tidx();
    if (tid < 64) {
        float hcar = 0.f;
        for (int c = 0; c < 16; ++c) {
            const size_t u = (size_t)uc * 16 + c;
            LRH0[u * 64 + tid] = hcar;
            hcar = __hip_atomic_load(LRAB + u * 128 + tid, __ATOMIC_RELAXED, __HIP_MEMORY_SCOPE_AGENT) * hcar + __hip_atomic_load(LRAB + u * 128 + 64 + tid, __ATOMIC_RELAXED, __HIP_MEMORY_SCOPE_AGENT);
        }
    }
}
__device__ __forceinline__ void phase_lru_combine(const Params& p, int l) {
    bf16_t* P = (bf16_t*)(p.ws + OFF_P); const bf16_t* HF0 = (const bf16_t*)(p.ws + OFF_HF); const bf16_t* HF1 = (const bf16_t*)(p.ws + OFF_HF1);
    const int nrows = l == 0 ? T : TX;
    for (int i = blockIdx.x * NTHR + tidx(); i < nrows * 32; i += gridDim.x * NTHR) {
        const int row = i >> 5, c = (i & 31) * 8;
        bf16_t* gp = P + (size_t)row * NP + LRO + c;
        union { uint4 q; bf16_t h[8]; } a, bq, gq, o;
        a.q = *(const uint4*)(HF0 + (size_t)row * 256 + c); bq.q = *(const uint4*)(HF1 + (size_t)row * 256 + c); gq.q = *(const uint4*)gp;
#pragma unroll
        for (int k = 0; k < 8; ++k) o.h[k] = f2bf((bf2f(a.h[k]) + bf2f(bq.h[k])) * gelu_tanh(bf2f(gq.h[k])));
        *(uint4*)gp = o.q;
    }
}

__device__ __forceinline__ bf16_t* zt_ptr(const Params& p, int var, int b, int col) {
    if (var) return (bf16_t*)(p.ws + OFF_HF) + ((size_t)b * 768 + col) * 256;
    if (col < 512) return (bf16_t*)(p.ws + OFF_ZTA) + ((size_t)b * 512 + col) * 4096;
    return (bf16_t*)(p.ws + OFF_RWOUT) + ((size_t)b * 256 + (col - 512)) * 4096;
}
__device__ __forceinline__ void phase_hyprep(const Params& p, int l, unsigned char* lds) {
    const bf16_t* P = (const bf16_t*)(p.ws + OFF_P);
    float* tile = (float*)lds;
    const float* cw = p.in[9] + (size_t)l * 3 * 768; const float* cb = p.in[10] + l * 768;
    const int tid = tidx(), cc = tid & 63, rq = tid >> 6;
    const int nux = 8 * 64 * 12, nuc = l == 0 ? 8 * 4 * 12 : 0;
    for (int u = blockIdx.x; u < nux + nuc; u += gridDim.x) {
        int var, b, tt, ct;
        if (u < nux) { var = 0; b = u / 768; const int r = u % 768; tt = r / 12; ct = r % 12; }
        else { const int k = u - nux; var = 1; b = k / 48; const int r = k % 48; tt = r / 12; ct = r % 12; }
        const int n = var ? CL : SEQ, rowb = var ? TX + b * CL : b * SEQ, t0 = tt * 64, col0 = ct * 64;
        __syncthreads();
        for (int q = tid; q < 66 * 8; q += NTHR) {
            const int r = q >> 3, c8 = (q & 7) * 8, t = t0 - 1 + r;
            union { uint4 v; bf16_t h[8]; } ld; ld.v = make_uint4(0u, 0u, 0u, 0u);
            if (t >= 0 && t < n) ld.v = *(const uint4*)(P + (size_t)(rowb + t) * NP + HYO + col0 + c8);
#pragma unroll
            for (int k = 0; k < 8; ++k) tile[r * 65 + c8 + k] = bf2f(ld.h[k]);
        }
        __syncthreads();
#pragma unroll 4
        for (int i = 0; i < 16; ++i) {
            const int cl = rq * 16 + i, col = col0 + cl;
            const float z = cb[col] + cw[col] * tile[cc * 65 + cl] + cw[768 + col] * tile[(cc + 1) * 65 + cl] + cw[1536 + col] * tile[(cc + 2) * 65 + cl];
            zt_ptr(p, var, b, col)[t0 + cc] = f2bf(z);
        }
    }
    __syncthreads();
}

template <bool DA, bool DB>
__device__ __forceinline__ void hy_dstep(f32x4 (&acc)[8][2], const bf16_t* rbase, const bf16_t* za, const bf16_t* zb, bool va, bool vb) {
#pragma unroll
    for (int ks = 0; ks < 4; ++ks) {
        union { uint4 q[2]; unsigned d[8]; } raw;
        raw.q[0] = *(const uint4*)(rbase + 32 * ks); raw.q[1] = *(const uint4*)(rbase + 32 * ks + 8);
        union { uint4 q; bf16x8 v; } fa, fb2;
        fa.q = make_uint4(0u, 0u, 0u, 0u); fb2.q = fa.q;
        if (DA) { fa.q = *(const uint4*)(za + 32 * ks); if (!va) fa.q = make_uint4(0u, 0u, 0u, 0u); }
        if (DB) { fb2.q = *(const uint4*)(zb + 32 * ks); if (!vb) fb2.q = make_uint4(0u, 0u, 0u, 0u); }
#pragma unroll
        for (int ph = 0; ph < 8; ++ph) {
            union { unsigned d[4]; bf16x8 v; } af;
            if ((ph & 1) == 0) {
#pragma unroll
                for (int k = 0; k < 4; ++k) af.d[k] = raw.d[4 - ph / 2 + k];
            } else {
                const int a0 = (7 - ph) / 2;
#pragma unroll
                for (int k = 0; k < 4; ++k) af.d[k] = __builtin_amdgcn_alignbit(raw.d[a0 + k + 1], raw.d[a0 + k], 16);
            }
            if (DA) acc[ph][0] = __builtin_amdgcn_mfma_f32_16x16x32_bf16(af.v, fa.v, acc[ph][0], 0, 0, 0);
            if (DB) acc[ph][1] = __builtin_amdgcn_mfma_f32_16x16x32_bf16(af.v, fb2.v, acc[ph][1], 0, 0, 0);
        }
    }
}
__device__ __forceinline__ void hy_conv32(const bf16_t* x, int t0, int n, float w0, float w1, float w2, float cb, float (&z)[32]) {
    union { uint4 q[4]; bf16_t hh[32]; } r;
#pragma unroll
    for (int k = 0; k < 4; ++k) r.q[k] = *(const uint4*)(x + 8 * k);
    float prev = t0 > 0 ? bf2f(x[-1]) : 0.f, cur = bf2f(r.hh[0]);
    const float last = t0 + 32 < n ? bf2f(x[32]) : 0.f;
#pragma unroll
    for (int i = 0; i < 32; ++i) {
        const float nx = i < 31 ? bf2f(r.hh[i + 1]) : last;
        z[i] = cb + w0 * prev + w1 * cur + w2 * nx;
        prev = cur; cur = nx;
    }
}
__device__ __forceinline__ void hyena_mfma_unit(const Params& p, int l, int u, unsigned char* lds) {
    bf16_t* P = (bf16_t*)(p.ws + OFF_P);
    const float* F = (const float*)(p.ws + OFF_FILT); const float* NORM = (const float*)(p.ws + OFF_NORM);
    const int bh = u >> 8, c = u & 255;
    bf16_t* Rb = (bf16_t*)lds;
    bf16_t* Zs = Rb + 8208;
    const int tid = tidx(), lane = tid & 63, wid = tid >> 6, lr = lane & 15, g = lane >> 4;
    const int bi = lr & 3, t1l = lr >> 2;
    __syncthreads();
    const float* hcw = p.in[9] + (size_t)l * 3 * 768; const float* hcb = p.in[10] + l * 768;
    {
        const float w0 = hcw[c], w1 = hcw[768 + c], w2 = hcw[1536 + c], cb0 = hcb[c];
        for (int q = tid; q < 2048; q += NTHR) {
            const int bq = q >> 9, tq = (q & 511) * 8;
            const bf16_t* xp = zt_ptr(p, 0, bh * 4 + bq, c) + tq;
            union { uint4 qv; bf16_t hh[8]; } xi, zo8;
            xi.qv = *(const uint4*)xp;
            float prev = tq > 0 ? bf2f(xp[-1]) : 0.f, cur = bf2f(xi.hh[0]);
            const float last = tq + 8 < SEQ ? bf2f(xp[8]) : 0.f;
#pragma unroll
            for (int i = 0; i < 8; ++i) {
                const float nx = i < 7 ? bf2f(xi.hh[i + 1]) : last;
                zo8.hh[i] = f2bf(cb0 + w0 * prev + w1 * cur + w2 * nx);
                prev = cur; cur = nx;
            }
            *(uint4*)(Zs + ((tq >> 7) * 4 + bq) * 136 + (tq & 127)) = zo8.qv;
        }
    }
#pragma unroll 1
    for (int o = 0; o < 2; ++o) {
        {
            const float inv = 1.0f / NORM[o * 256 + c];
            const float skip = p.in[16][(l * 2 + o) * 256 + c];
            const float* ff = F + (size_t)(o * 512 + c) * 4096; const float* fb = ff + (size_t)256 * 4096;
            for (int dl = tid; dl < 4096; dl += NTHR) {
                float vf = ff[dl] * inv; if (dl == 0) vf += skip;
                Rb[4096 - dl] = f2bf(vf);
                if (dl > 0) Rb[4096 + dl] = f2bf(fb[dl] * inv);
            }
            if (tid < 17) Rb[tid == 16 ? 0 : 8192 + tid] = 0;
        }
        __syncthreads();
        f32x4 acc[8][2];
#pragma unroll
        for (int ph = 0; ph < 8; ++ph) { acc[ph][0] = (f32x4){0.f, 0.f, 0.f, 0.f}; acc[ph][1] = (f32x4){0.f, 0.f, 0.f, 0.f}; }
#pragma unroll 1
        for (int d1 = -31; d1 <= 31; ++d1) {
            const int s1a = 8 * wid - d1, s1b = s1a + 4;
            const bool ta = (s1a + 3 >= 0) && (s1a <= 31), tb = (s1b + 3 >= 0) && (s1b <= 31);
            if (!ta && !tb) continue;
            const int sa = s1a + t1l, sb = s1b + t1l;
            const bool va = (unsigned)sa < 32u, vb = (unsigned)sb < 32u;
            const bf16_t* za = Zs + ((va ? sa : 0) * 4 + bi) * 136 + g * 8;
            const bf16_t* zb = Zs + ((vb ? sb : 0) * 4 + bi) * 136 + g * 8;
            const bf16_t* rbase = Rb + 4096 + g * 8 - 8 * lr - 128 * d1 - 8;
            if (ta && tb) hy_dstep<true, true>(acc, rbase, za, zb, va, vb);
            else if (ta) hy_dstep<true, false>(acc, rbase, za, zb, va, vb);
            else hy_dstep<false, true>(acc, rbase, za, zb, va, vb);
        }
        __syncthreads();
        if (o == 0) {
#pragma unroll
            for (int ni = 0; ni < 2; ++ni) {
                const int t1 = 8 * wid + 4 * ni + t1l, b = bh * 4 + bi;
                float gz[32];
                hy_conv32(zt_ptr(p, 0, b, 256 + c) + t1 * 128 + 32 * g, t1 * 128 + 32 * g, SEQ, hcw[256 + c], hcw[768 + 256 + c], hcw[1536 + 256 + c], hcb[256 + c], gz);
                bf16_t* zo = Zs + (t1 * 4 + bi) * 136 + 32 * g;
#pragma unroll
                for (int ph = 0; ph < 8; ++ph)
#pragma unroll
                    for (int j = 0; j < 4; ++j) zo[ph + 8 * j] = f2bf(gz[ph + 8 * j] * acc[ph][ni][j]);
            }
        } else {
#pragma unroll
            for (int ni = 0; ni < 2; ++ni) {
                const int t1 = 8 * wid + 4 * ni + t1l, b = bh * 4 + bi;
                float gz[32];
                hy_conv32(zt_ptr(p, 0, b, 512 + c) + t1 * 128 + 32 * g, t1 * 128 + 32 * g, SEQ, hcw[512 + c], hcw[768 + 512 + c], hcw[1536 + 512 + c], hcb[512 + c], gz);
                const int prow = b * SEQ + t1 * 128 + 32 * g;
#pragma unroll
                for (int ph = 0; ph < 8; ++ph) {
                    int phv = ph; asm volatile("" : "+v"(phv));
#pragma unroll
                    for (int j = 0; j < 4; ++j) P[(size_t)(prow + phv + 8 * j) * NP + HYO + c] = f2bf(gz[ph + 8 * j] * acc[ph][ni][j]);
                }
            }
        }
        __syncthreads();
    }
}

__device__ __forceinline__ void hyena_ctx_unit(const Params& p, int l, int c, unsigned char* lds) {
    bf16_t* P = (bf16_t*)(p.ws + OFF_P);
    const float* FC = (const float*)(p.ws + OFF_FILT) + (size_t)4096 * 1024; const float* NORM = (const float*)(p.ws + OFF_NORM);
    float* Hc = (float*)lds;
    float* zin = Hc + 512;
    const int t = tidx();
    const float* hcw = p.in[9] + (size_t)l * 3 * 768; const float* hcb = p.in[10] + l * 768;
    __syncthreads();
#pragma unroll
    for (int b = 0; b < 8; ++b) {
        const bf16_t* xp = zt_ptr(p, 1, b, c) + t;
        zin[b * 256 + t] = hcb[c] + hcw[c] * (t > 0 ? bf2f(xp[-1]) : 0.f) + hcw[768 + c] * bf2f(xp[0]) + hcw[1536 + c] * (t < 255 ? bf2f(xp[1]) : 0.f);
    }
#pragma unroll 1
    for (int o = 0; o < 2; ++o) {
        const float inv = 1.0f / NORM[(2 + o) * 256 + c];
        const float* ff = FC + (size_t)(o * 512 + c) * 256; const float* fb = ff + (size_t)256 * 256;
        float vf = ff[t] * inv; if (t == 0) vf += p.in[16][(l * 2 + o) * 256 + c];
        Hc[255 + t] = vf;
        if (t > 0) Hc[255 - t] = fb[t] * inv;
        if (t == 0) Hc[511] = 0.f;
        __syncthreads();
        float y[8];
#pragma unroll
        for (int b = 0; b < 8; ++b) y[b] = 0.f;
        for (int s = 0; s < 256; ++s) {
            const float hv = Hc[t - s + 255];
#pragma unroll
            for (int b = 0; b < 8; ++b) y[b] += hv * zin[b * 256 + s];
        }
        __syncthreads();
#pragma unroll
        for (int b = 0; b < 8; ++b) {
            const int gc = (o == 0 ? 256 : 512) + c;
            const bf16_t* gp = zt_ptr(p, 1, b, gc) + t;
            const float gt = hcb[gc] + hcw[gc] * (t > 0 ? bf2f(gp[-1]) : 0.f) + hcw[768 + gc] * bf2f(gp[0]) + hcw[1536 + gc] * (t < 255 ? bf2f(gp[1]) : 0.f);
            if (o == 0) zin[b * 256 + t] = gt * y[b];
            else P[(size_t)(TX + b * CL + t) * NP + HYO + c] = f2bf(gt * y[b]);
        }
        __syncthreads();
    }
}

__device__ __forceinline__ void rwkv_readout_unit(const Params& p, int l, int u, unsigned char* lds) {
    const bf16_t* P = (const bf16_t*)(p.ws + OFF_P); const bf16_t* YRW = (const bf16_t*)(p.ws + OFF_YRW); bf16_t* RWOUT = (bf16_t*)(p.ws + OFF_RWOUT);
    bf16_t* sm = (bf16_t*)lds;
    bf16_t* raw = sm + 16 * 768;
    bf16_t* dbh = raw;
    bf16_t* xa = (bf16_t*)(lds + 61440);
    bf16_t* xg = xa + 2 * 16 * 72;
    const int tid = tidx(), row0 = u * 16;
    const bool isx = row0 < TX;
    const int n = isx ? SEQ : CL;
    const float* mu0 = p.in[17] + (size_t)l * 2 * 1152; const float* mu1 = mu0 + 1152;
    __syncthreads();
    {
        const int tb = isx ? (row0 & 4095) : ((row0 - TX) & 255);
        for (int q = tid; q < 18 * 128; q += NTHR) {
            const int rr = q >> 7, part = q & 127, tt = tb - 1 + rr;
            uint4 v = make_uint4(0u, 0u, 0u, 0u);
            if (tt >= 0 && tt < n) v = *(const uint4*)(P + (size_t)(row0 - 1 + rr) * NP + RWO + part * 8 + (part >= 96 ? 128 : 0));
            *(uint4*)(raw + rr * 1024 + part * 8) = v;
        }
    }
    __syncthreads();
    for (int lc = tid; lc < 1024; lc += NTHR) {
        const int col = lc + (lc >= 768 ? 128 : 0);
        const float m0 = mu0[col], m1 = mu1[col];
        const bf16_t* pr = raw + lc;
        float prev = bf2f(pr[0]), cur = bf2f(pr[1024]);
#pragma unroll
        for (int tok = 0; tok < 16; ++tok) {
            const float nxt = bf2f(pr[(tok + 2) * 1024]);
            const float v = cur + (prev - cur) * m0 + (nxt - cur) * m1;
            if (lc < 768) sm[tok * 768 + lc] = f2bf(v);
            else if (lc < 896) xa[((lc - 768) >> 6) * (16 * 72) + tok * 72 + ((lc - 768) & 63)] = f2bf(v);
            else xg[tok * 136 + (lc - 896)] = f2bf(sigmoidf_(v));
            prev = cur; cur = nxt;
        }
    }
    __syncthreads();
    {
        const int lane = tid & 63, wid = tid >> 6, lr = lane & 15, g = lane >> 4;
        const bf16_t* A2T = (const bf16_t*)(p.ws + OFF_RWL); const bf16_t* G2T = A2T + 2 * 256 * 64;
#pragma unroll 1
        for (int nt = 0; nt < 4; ++nt) {
            const int cq = 64 * wid + 16 * nt + lr;
            f32x4 d0 = {0.f, 0.f, 0.f, 0.f}, d1 = {0.f, 0.f, 0.f, 0.f}, dg = {0.f, 0.f, 0.f, 0.f};
#pragma unroll
            for (int ks = 0; ks < 2; ++ks) {
                const bf16x8 x0 = *(const bf16x8*)(xa + lr * 72 + ks * 32 + g * 8), x1 = *(const bf16x8*)(xa + 16 * 72 + lr * 72 + ks * 32 + g * 8);
                const bf16x8 b0 = *(const bf16x8*)(A2T + (size_t)cq * 64 + ks * 32 + g * 8), b1 = *(const bf16x8*)(A2T + 256 * 64 + (size_t)cq * 64 + ks * 32 + g * 8);
                d0 = __builtin_amdgcn_mfma_f32_16x16x32_bf16(x0, b0, d0, 0, 0, 0);
                d1 = __builtin_amdgcn_mfma_f32_16x16x32_bf16(x1, b1, d1, 0, 0, 0);
            }
#pragma unroll
            for (int ks = 0; ks < 4; ++ks) {
                const bf16x8 xv = *(const bf16x8*)(xg + lr * 136 + ks * 32 + g * 8);
                const bf16x8 bg = *(const bf16x8*)(G2T + (size_t)cq * 128 + ks * 32 + g * 8);
                dg = __builtin_amdgcn_mfma_f32_16x16x32_bf16(xv, bg, dg, 0, 0, 0);
            }
#pragma unroll
            for (int j = 0; j < 4; ++j) { const int tk = 4 * g + j; dbh[tk * 256 + cq] = f2bf(d0[j]); dbh[(16 + tk) * 256 + cq] = f2bf(d1[j]); dbh[(32 + tk) * 256 + cq] = f2bf(dg[j]); }
        }
    }
    __syncthreads();
    const int c = tid;
    const float a00 = p.in[20][(l * 2 + 0) * 256 + c], a01 = p.in[20][(l * 2 + 1) * 256 + c];
    const float ka = p.in[24][l * 256 + c], rk = p.in[25][l * 256 + c], lw = p.in[26][l * 256 + c], lb = p.in[27][l * 256 + c];
#pragma unroll 4
    for (int k = 0; k < 16; ++k) {
        const int row = row0 + k;
        const float s0 = sigmoidf_(a00 + bf2f(dbh[k * 256 + c])), s1 = sigmoidf_(a01 + bf2f(dbh[(16 + k) * 256 + c])), gvk = bf2f(dbh[(32 + k) * 256 + c]);
        const float kv = bf2f(sm[k * 768 + 256 + c]), rr = bf2f(sm[k * 768 + c]), vv = bf2f(sm[k * 768 + 512 + c]);
        const float kd = kv * (1.f + (s0 - 1.f) * ka) + kv * (1.f + (s1 - 1.f) * ka);
        const float cs = wave_sum(rr * kd * rk);
        const float yv = bf2f(YRW[(size_t)row * 256 + c]) + bf2f(YRW[((size_t)T + row) * 256 + c]);
        const float mean = wave_sum(yv) * (1.0f / 64.0f);
        const float dv = yv - mean;
        const float var = wave_sum(dv * dv) * (1.0f / 64.0f);
        const float yn = dv * rsqrtf(var + 64e-5f) * lw + lb;
        RWOUT[(size_t)row * 256 + c] = f2bf((yn + cs * vv) * gvk);
    }
    __syncthreads();
}

struct PhMerge {
    bf16_t* P; const bf16_t* HX; const bf16_t* WIN; const bf16_t* WBR; const bf16_t* RWOUT; int wr, wc, lr, g;
    unsigned gsp[4][4][2], mac[4][4][2];
    static constexpr int nseg = 8;
    __device__ __forceinline__ bool valid(int, int) const { return true; }
    __device__ __forceinline__ int nk(int s) const { return (s & 1) ? (s == 1 ? 8 : 4) : 16; }
    __device__ __forceinline__ const bf16_t* arow(int mt, int, int s, int r) const {
        const int m = mt * 128 + r;
        if (!(s & 1)) return HX + (size_t)m * 1024;
        if (s == 1) return P + (size_t)m * NP + QO;
        if (s == 3) return P + (size_t)m * NP + HYO;
        if (s == 5) return RWOUT + (size_t)m * 256;
        return P + (size_t)m * NP + LRO;
    }
    __device__ __forceinline__ const bf16_t* brow(int, int nt, int s, int r) const {
        const int n = nt * 128 + r;
        if (!(s & 1)) return WIN + (size_t)(GTO + (s >> 1) * 1024 + n) * 1024;
        return WBR + (size_t)n * 1280 + (s == 1 ? 0 : (s == 3 ? 512 : (s == 5 ? 768 : 1024)));
    }
    __device__ __forceinline__ void seg_end(int mt, int nt, int s, f32x4 (&acc)[4][4]) {
        if (!(s & 1)) {
#pragma unroll
            for (int ni = 0; ni < 4; ++ni)
#pragma unroll
                for (int mi = 0; mi < 4; ++mi) {
                    float sg[4];
#pragma unroll
                    for (int j = 0; j < 4; ++j) sg[j] = __builtin_amdgcn_rcpf(1.0f + __expf(-acc[ni][mi][j]));
                    gsp[ni][mi][0] = pack2(sg[0], sg[1]); gsp[ni][mi][1] = pack2(sg[2], sg[3]);
                    acc[ni][mi] = (f32x4){0.f, 0.f, 0.f, 0.f};
                }
        } else {
#pragma unroll
            for (int ni = 0; ni < 4; ++ni)
#pragma unroll
                for (int mi = 0; mi < 4; ++mi) {
                    const unsigned g0 = gsp[ni][mi][0], g1 = gsp[ni][mi][1];
                    const f32x4 gs = {__uint_as_float(g0 << 16), __uint_as_float(g0 & 0xffff0000u), __uint_as_float(g1 << 16), __uint_as_float(g1 & 0xffff0000u)};
                    const unsigned m0 = mac[ni][mi][0], m1 = mac[ni][mi][1];
                    const f32x4 ms = {__uint_as_float(m0 << 16), __uint_as_float(m0 & 0xffff0000u), __uint_as_float(m1 << 16), __uint_as_float(m1 & 0xffff0000u)};
                    const f32x4 r = ms + gs * acc[ni][mi];
                    mac[ni][mi][0] = pack2(r[0], r[1]); mac[ni][mi][1] = pack2(r[2], r[3]);
                    acc[ni][mi] = (f32x4){0.f, 0.f, 0.f, 0.f};
                }
            if (s == 7) {
                const int t_ = tidx(), lr_ = t_ & 15, g_ = (t_ >> 4) & 3, wc_ = (t_ >> 6) & 1, wr_ = t_ >> 7;
#pragma unroll
                for (int ni = 0; ni < 4; ++ni)
#pragma unroll
                    for (int mi = 0; mi < 4; ++mi) {
                        const int m = mt * 128 + wr_ * 64 + mi * 16 + lr_, n = nt * 128 + wc_ * 64 + ni * 16 + g_ * 4;
                        uint2 o; o.x = mac[ni][mi][0]; o.y = mac[ni][mi][1];
                        *(uint2*)(P + (size_t)m * NP + RWO + n) = o;
                        mac[ni][mi][0] = 0u; mac[ni][mi][1] = 0u;
                    }
            }
        }
    }
};
__device__ __forceinline__ void phase_merge(const Params& p, int l, unsigned char* lds) {
    const int lane = tidx() & 63, wid = tidx() >> 6;
    PhMerge ph;
    ph.P = (bf16_t*)(p.ws + OFF_P); ph.HX = (const bf16_t*)(p.ws + OFF_HX); ph.WIN = (const bf16_t*)(p.ws + OFF_WIN);
    ph.WBR = (const bf16_t*)(p.ws + OFF_WBR); ph.RWOUT = (const bf16_t*)(p.ws + OFF_RWOUT);
    ph.wr = wid >> 1; ph.wc = wid & 1; ph.lr = lane & 15; ph.g = lane >> 4;
#pragma unroll
    for (int ni = 0; ni < 4; ++ni)
#pragma unroll
        for (int mi = 0; mi < 4; ++mi) { ph.mac[ni][mi][0] = 0u; ph.mac[ni][mi][1] = 0u; ph.gsp[ni][mi][0] = 0u; ph.gsp[ni][mi][1] = 0u; }
    const TileSched ts_(l == 0 ? 272 : 256, 8);
    gemm_stream<4>(ph, ts_, lds);
}

struct PhWout {
    const Params* pp; const bf16_t* P; const bf16_t* WOUT; const float* MOD; int l; int wr, wc, lr, g;
    static constexpr int nseg = 1;
    __device__ __forceinline__ bool valid(int, int) const { return true; }
    __device__ __forceinline__ int nk(int) const { return 16; }
    __device__ __forceinline__ const bf16_t* arow(int mt, int, int, int r) const { return P + (size_t)(mt * 128 + r) * NP + RWO; }
    __device__ __forceinline__ const bf16_t* brow(int, int nt, int, int r) const { return WOUT + (size_t)(nt * 128 + r) * 1024; }
    __device__ __forceinline__ void seg_end(int mt, int nt, int, f32x4 (&acc)[4][4]) const {
#pragma unroll
        for (int mi = 0; mi < 4; ++mi) {
            const int m = mt * 128 + wr * 64 + mi * 16 + lr;
            const float* src = stream_in_row(*pp, l, m); float* dst = stream_out_row(*pp, m);
            const float* g1 = MOD + (size_t)(l * 9 + mod_row(m)) * 6144 + 2048;
#pragma unroll
            for (int ni = 0; ni < 4; ++ni) {
                const int n = nt * 128 + wc * 64 + ni * 16 + g * 4;
                const f32x4 xin = *(const f32x4*)(src + n), gg = *(const f32x4*)(g1 + n);
                *(f32x4*)(dst + n) = xin + gg * acc[ni][mi];
                acc[ni][mi] = (f32x4){0.f, 0.f, 0.f, 0.f};
            }
        }
    }
};
__device__ __forceinline__ void phase_wout(const Params& p, int l, unsigned char* lds) {
    const int lane = tidx() & 63, wid = tidx() >> 6;
    PhWout ph{&p, (const bf16_t*)(p.ws + OFF_P), (const bf16_t*)(p.ws + OFF_WOUT), (const float*)(p.ws + OFF_MOD), l, wid >> 1, wid & 1, lane & 15, lane >> 4};
    const TileSched ts_(l == 0 ? 272 : 256, 8);
    gemm_stream<4>(ph, ts_, lds);
}

__device__ __forceinline__ void phase_route(const Params& p, int l, unsigned char* lds) {
    const int lane = tidx() & 63, gw = blockIdx.x * 4 + (tidx() >> 6), nw = gridDim.x * 4;
    bf16_t* HX = (bf16_t*)(p.ws + OFF_HX);
    const float* MOD = (const float*)(p.ws + OFF_MOD);
    int* CNT = (int*)(p.ws + OFF_CNT); int* RTE = (int*)(p.ws + OFF_RTE); float2* RTW = (float2*)(p.ws + OFF_RTW); int* ROWTOK = (int*)(p.ws + OFF_ROWTOK);
    for (int i = blockIdx.x * NTHR + tidx(); i < MAXROWS; i += gridDim.x * NTHR) ROWTOK[i] = -1;
    int* hist = (int*)lds;
    float* wgs = (float*)(lds + 256);
    const float* wg = p.in[40] + (size_t)l * 1024 * 4; const float* wrt = p.in[42] + (size_t)l * 1024 * 16;
    __syncthreads();
    if (tidx() < 16) hist[tidx()] = 0;
    for (int i = tidx(); i < 1024; i += NTHR) *(f32x4*)(wgs + i * 4) = *(const f32x4*)(wg + i * 4);
    __syncthreads();
    const int nrows = l == 0 ? T : TX;
    for (int row = gw; row < nrows; row += nw) {
        const float* src = stream_out_row(p, row);
        f32x4 v[4]; float ss = 0.f;
#pragma unroll
        for (int i = 0; i < 4; ++i) { v[i] = *(const f32x4*)(src + i * 256 + lane * 4); ss += v[i][0] * v[i][0] + v[i][1] * v[i][1] + v[i][2] * v[i][2] + v[i][3] * v[i][3]; }
        ss = wave_sum(ss);
        const float rstd = rsqrtf(ss * (1.0f / 1024.0f) + 1e-6f);
        const float* mod = MOD + (size_t)(l * 9 + mod_row(row)) * 6144;
        float lg[4] = {0.f, 0.f, 0.f, 0.f}, hv[4][4];
#pragma unroll
        for (int i = 0; i < 4; ++i) {
            const int k = i * 256 + lane * 4;
            const f32x4 sh = *(const f32x4*)(mod + 3072 + k), sc = *(const f32x4*)(mod + 4096 + k);
#pragma unroll
            for (int j = 0; j < 4; ++j) hv[i][j] = v[i][j] * rstd * (1.f + sc[j]) + sh[j];
            uint2 o; o.x = pack2(hv[i][0], hv[i][1]); o.y = pack2(hv[i][2], hv[i][3]);
            *(uint2*)(HX + (size_t)row * 1024 + k) = o;
#pragma unroll
            for (int j = 0; j < 4; ++j) {
                const f32x4 w4 = *(const f32x4*)(wgs + (k + j) * 4);
                lg[0] += hv[i][j] * w4[0]; lg[1] += hv[i][j] * w4[1]; lg[2] += hv[i][j] * w4[2]; lg[3] += hv[i][j] * w4[3];
            }
        }
#pragma unroll
        for (int c = 0; c < 4; ++c) lg[c] = wave_sum(lg[c]) + p.in[41][l * 4 + c];
        int gi = 0; float gm = lg[0];
#pragma unroll
        for (int c = 1; c < 4; ++c) if (lg[c] > gm) { gm = lg[c]; gi = c; }
        gi = __builtin_amdgcn_readfirstlane(gi);
        float el[4] = {0.f, 0.f, 0.f, 0.f};
#pragma unroll
        for (int i = 0; i < 4; ++i)
#pragma unroll
            for (int j = 0; j < 4; ++j) {
                const f32x4 r4 = *(const f32x4*)(wrt + (size_t)(i * 256 + lane * 4 + j) * 16 + gi * 4);
                el[0] += hv[i][j] * r4[0]; el[1] += hv[i][j] * r4[1]; el[2] += hv[i][j] * r4[2]; el[3] += hv[i][j] * r4[3];
            }
#pragma unroll
        for (int c = 0; c < 4; ++c) el[c] = wave_sum(el[c]) + p.in[43][l * 16 + gi * 4 + c];
        if (lane == 0) {
            float gs = 0.f;
#pragma unroll
            for (int c = 0; c < 4; ++c) gs += expf(lg[c] - gm);
            const float gval = 1.0f / gs;
            int ia = 0; float ma = el[0];
#pragma unroll
            for (int c = 1; c < 4; ++c) if (el[c] > ma) { ma = el[c]; ia = c; }
            int ib = -1; float mb = -3.0e38f;
#pragma unroll
            for (int c = 0; c < 4; ++c) if (c != ia && el[c] > mb) { mb = el[c]; ib = c; }
            const float eb = expf(mb - ma);
            const float wa = gval / (1.0f + eb), wb = gval * eb / (1.0f + eb);
            const int ea = gi * 4 + ia, ebi = gi * 4 + ib;
            RTE[row] = ea | (ebi << 8);
            RTW[row] = make_float2(wa, wb);
            atomicAdd(&hist[ea], 1); atomicAdd(&hist[ebi], 1);
        }
    }
    __syncthreads();
    if (tidx() < 16 && hist[tidx()] > 0) atomicAdd(&CNT[tidx()], hist[tidx()]);
    __syncthreads();
}

__device__ __forceinline__ void moe_offsets(const Params& p, int* off  ) {
    const int* CNT = (const int*)(p.ws + OFF_CNT);
    __syncthreads();
    if (tidx() == 0) { int a = 0; for (int e = 0; e < 16; ++e) { off[e] = a; a += (__hip_atomic_load(CNT + e, __ATOMIC_RELAXED, __HIP_MEMORY_SCOPE_AGENT) + 127) & ~127; } off[16] = a; }
    __syncthreads();
}

__device__ __forceinline__ void phase_lists(const Params& p, int l, unsigned char* lds) {
    int* off = (int*)lds;
    int* hist = off + 32;
    int* base = off + 64;
    moe_offsets(p, off);
    int* CNT = (int*)(p.ws + OFF_CNT); const int* RTE = (const int*)(p.ws + OFF_RTE); int* TOKPOS = (int*)(p.ws + OFF_TOKPOS); int* ROWTOK = (int*)(p.ws + OFF_ROWTOK);
    const int nrows = l == 0 ? T : TX, tid = tidx();
    for (int i0 = blockIdx.x * NTHR; i0 < nrows * 2; i0 += gridDim.x * NTHR) {
        const int i = i0 + tid;
        const bool ok = i < nrows * 2;
        if (tid < 16) hist[tid] = 0;
        __syncthreads();
        int e = 0, lrank = 0;
        if (ok) { e = (RTE[i >> 1] >> ((i & 1) * 8)) & 255; lrank = atomicAdd(&hist[e], 1); }
        __syncthreads();
        if (tid < 16) base[tid] = hist[tid] > 0 ? atomicAdd(&CNT[16 + tid], hist[tid]) : 0;
        __syncthreads();
        if (ok) { const int pos = off[e] + base[e] + lrank; ROWTOK[pos] = i >> 1; TOKPOS[i] = pos; }
        __syncthreads();
    }
}

__device__ __forceinline__ int moe_expert(const int* off, int rt) {
    int e = 0;
#pragma unroll
    for (int q = 1; q < 16; ++q) if (rt * 128 >= off[q]) e = q;
    return e;
}
struct PhUp {
    const bf16_t* HX; const bf16_t* W13; bf16_t* H; const int* ROWTOK; const int* off; int wr, wc, lr, g;
    static constexpr int nseg = 1;
    __device__ __forceinline__ bool valid(int, int) const { return true; }
    __device__ __forceinline__ int nk(int) const { return 16; }
    __device__ __forceinline__ const bf16_t* arow(int rt, int, int, int r) const { const int t = ROWTOK[rt * 128 + r]; return HX + (size_t)(t < 0 ? 0 : t) * 1024; }
    __device__ __forceinline__ const bf16_t* brow(int rt, int nt, int, int r) const { return W13 + ((size_t)moe_expert(off, rt) * 1024 + nt * 128 + r) * 1024; }
    __device__ __forceinline__ void seg_end(int rt, int nt, int, f32x4 (&acc)[4][4]) const {
#pragma unroll
        for (int np = 0; np < 2; ++np)
#pragma unroll
            for (int mi = 0; mi < 4; ++mi) {
                const int m = rt * 128 + wr * 64 + mi * 16 + lr;
                const int hc = (nt * 128 + wc * 64 + np * 32) / 2 + g * 4;
                float hv[4];
#pragma unroll
                for (int j = 0; j < 4; ++j) { const float a = acc[2 * np][mi][j], bq = acc[2 * np + 1][mi][j]; hv[j] = a * __builtin_amdgcn_rcpf(1.0f + __expf(-a)) * bq; }
                uint2 o; o.x = pack2(hv[0], hv[1]); o.y = pack2(hv[2], hv[3]);
                *(uint2*)(H + (size_t)m * 512 + hc) = o;
                acc[2 * np][mi] = (f32x4){0.f, 0.f, 0.f, 0.f}; acc[2 * np + 1][mi] = (f32x4){0.f, 0.f, 0.f, 0.f};
            }
    }
};
__device__ __forceinline__ void phase_moe_up(const Params& p, unsigned char* lds) {
    int* off = (int*)(lds + LDS_BYTES - 256);
    moe_offsets(p, off);
    const int lane = tidx() & 63, wid = tidx() >> 6;
    PhUp ph{(const bf16_t*)(p.ws + OFF_HX), (const bf16_t*)(p.ws + OFF_W13), (bf16_t*)(p.ws + OFF_H), (const int*)(p.ws + OFF_ROWTOK), off, wid >> 1, wid & 1, lane & 15, lane >> 4};
    const TileSched ts_(off[16] >> 7, 8);
    gemm_stream<4>(ph, ts_, lds);
}

struct PhDown {
    const bf16_t* H; const bf16_t* W2; bf16_t* Y2; const int* off; int wr, wc, lr, g;
    static constexpr int nseg = 1;
    __device__ __forceinline__ bool valid(int, int) const { return true; }
    __device__ __forceinline__ int nk(int) const { return 8; }
    __device__ __forceinline__ const bf16_t* arow(int rt, int, int, int r) const { return H + (size_t)(rt * 128 + r) * 512; }
    __device__ __forceinline__ const bf16_t* brow(int rt, int nt, int, int r) const { return W2 + ((size_t)moe_expert(off, rt) * 1024 + nt * 128 + r) * 512; }
    __device__ __forceinline__ void seg_end(int rt, int nt, int, f32x4 (&acc)[4][4]) const {
#pragma unroll
        for (int ni = 0; ni < 4; ++ni)
#pragma unroll
            for (int mi = 0; mi < 4; ++mi) {
                const int m = rt * 128 + wr * 64 + mi * 16 + lr, n = nt * 128 + wc * 64 + ni * 16 + g * 4;
                uint2 o; o.x = pack2(acc[ni][mi][0], acc[ni][mi][1]); o.y = pack2(acc[ni][mi][2], acc[ni][mi][3]);
                *(uint2*)(Y2 + (size_t)m * 1024 + n) = o;
                acc[ni][mi] = (f32x4){0.f, 0.f, 0.f, 0.f};
            }
    }
};
__device__ __forceinline__ void phase_moe_down(const Params& p, unsigned char* lds) {
    int* off = (int*)(lds + LDS_BYTES - 256);
    moe_offsets(p, off);
    const int lane = tidx() & 63, wid = tidx() >> 6;
    PhDown ph{(const bf16_t*)(p.ws + OFF_H), (const bf16_t*)(p.ws + OFF_W2), (bf16_t*)(p.ws + OFF_Y2), off, wid >> 1, wid & 1, lane & 15, lane >> 4};
    const TileSched ts_(off[16] >> 7, 8);
    gemm_stream<4>(ph, ts_, lds);
}

__device__ __forceinline__ void phase_combine(const Params& p, int l) {
    const bf16_t* Y2 = (const bf16_t*)(p.ws + OFF_Y2); const int* TOKPOS = (const int*)(p.ws + OFF_TOKPOS); const float2* RTW = (const float2*)(p.ws + OFF_RTW);
    const float* MOD = (const float*)(p.ws + OFF_MOD);
    const int nrows = l == 0 ? T : TX, lane = tidx() & 63, gw = blockIdx.x * 4 + (tidx() >> 6), nw = gridDim.x * 4;
    for (int row = gw; row < nrows; row += nw) {
        const int p0 = TOKPOS[row * 2], p1 = TOKPOS[row * 2 + 1];
        const float2 w = RTW[row];
        const float* g2p = MOD + (size_t)(l * 9 + mod_row(row)) * 6144 + 5120 + lane * 4;
        float* dst = stream_out_row(p, row) + lane * 4;
        uint2 ya[4], yb[4]; f32x4 xv[4], g2[4];
#pragma unroll
        for (int i = 0; i < 4; ++i) {
            ya[i] = *(const uint2*)(Y2 + (size_t)p0 * 1024 + lane * 4 + i * 256); yb[i] = *(const uint2*)(Y2 + (size_t)p1 * 1024 + lane * 4 + i * 256);
            xv[i] = *(const f32x4*)(dst + i * 256); g2[i] = *(const f32x4*)(g2p + i * 256);
        }
#pragma unroll
        for (int i = 0; i < 4; ++i) {
            f32x4 x = xv[i];
            x[0] += g2[i][0] * (w.x * __uint_as_float(ya[i].x << 16) + w.y * __uint_as_float(yb[i].x << 16));
            x[1] += g2[i][1] * (w.x * __uint_as_float(ya[i].x & 0xffff0000u) + w.y * __uint_as_float(yb[i].x & 0xffff0000u));
            x[2] += g2[i][2] * (w.x * __uint_as_float(ya[i].y << 16) + w.y * __uint_as_float(yb[i].y << 16));
            x[3] += g2[i][3] * (w.x * __uint_as_float(ya[i].y & 0xffff0000u) + w.y * __uint_as_float(yb[i].y & 0xffff0000u));
            *(f32x4*)(dst + i * 256) = x;
        }
    }
}

__device__ __forceinline__ int next_unit(int* counter, unsigned char* lds) {
    int* sh = (int*)(lds + LDS_BYTES - 64);
    __syncthreads();
    if (tidx() == 0) sh[0] = atomicAdd(counter, 1);
    __syncthreads();
    return sh[0];
}
__device__ __forceinline__ void stage_mixA(const Params& p, int l, unsigned char* lds, int role) {
    int* CNT = (int*)(p.ws + OFF_CNT);
    const int nattn = l == 0 ? 1024 + 64 : 1024;
    const int ncommon = nattn + 1024 + 256;
    constexpr int N1 = 2;
    bool did_r = false; int ndone = 0;
    for (;;) {
        int ru = -1, cu = -1;
        if (!did_r && (role == 0 || ndone >= N1)) { did_r = true; ru = next_unit(&CNT[35], lds); if (ru >= 512) continue; }
        else {
            cu = next_unit(&CNT[32], lds);
            if (cu >= ncommon) { cu = -1; ru = next_unit(&CNT[35], lds); if (ru >= 512) break; } else ++ndone;
        }
        if (ru >= 0) rwkv_chunk_unit<0>(p, l, ru, lds);
        else if (cu < nattn) attn_unit(p, l, cu, lds);
        else if (cu < nattn + 1024) lru_chunk_unit<0>(p, l, cu - nattn, lds);
        else hy_norm_unit(p, cu - nattn - 1024, lds);
    }
}
__device__ __forceinline__ void stage_mixB(const Params& p, int l, unsigned char* lds) {
    int* CNT = (int*)(p.ws + OFF_CNT);
    const int nh = l == 0 ? 512 + 256 : 512;
    for (;;) {
        const int u = next_unit(&CNT[33], lds);
        if (u < 64) rwkv_passB_unit(p, u, lds);
        else if (u < 128) lru_passB_unit(p, u - 64);
        else if (u < 128 + 512) hyena_mfma_unit(p, l, u - 128, lds);
        else if (u < 128 + nh) hyena_ctx_unit(p, l, u - 128 - 512, lds);
        else break;
    }
}
__device__ __forceinline__ void stage_mixC(const Params& p, int l, unsigned char* lds) {
    int* CNT = (int*)(p.ws + OFF_CNT);
    for (;;) {
        const int u = next_unit(&CNT[34], lds);
        if (u < 1024) lru_chunk_unit<1>(p, l, u, lds);
        else if (u < 1536) rwkv_passC_unit(p, u - 1024, lds);
        else break;
    }
}
__device__ __forceinline__ void stage_mixD(const Params& p, int l, unsigned char* lds) {
    const int nr = (l == 0 ? T : TX) / 16;
    for (int u = blockIdx.x; u < nr; u += gridDim.x) rwkv_readout_unit(p, l, u, lds);
    phase_lru_combine(p, l);
}

__global__ void __launch_bounds__(NTHR, 2) __attribute__((target("no-packed-fp32-ops"))) fwd_kernel(Params p) {
    extern __shared__ __attribute__((aligned(16))) unsigned char lds[];
    volatile LAS unsigned* xb_words = (volatile LAS unsigned*)(LAS unsigned char*)(lds + LDS_BYTES - 128);
    if (threadIdx.x == 0) { xb_words[0] = 0u; xb_words[1] = 0u; xb_words[2] = 0u; xb_words[3] = 0u; }
    __syncthreads();
    XcdBarrier bar = xcd_barrier_post((unsigned*)(p.ws + OFF_BAR), xb_words);
    if (threadIdx.x == 0) {
        const unsigned key = bar.x * 256u + (((unsigned)__builtin_amdgcn_s_getreg(63492) >> 8) & 0xffu);
        xb_words[2] = (unsigned)atomicAdd((int*)(p.ws + OFF_CUSLOT) + key, 1);
    }
    __syncthreads();
    const int role = (int)(xb_words[2] & 1u);
    typedef __attribute__((address_space(1))) unsigned char gu8_t;
    typedef __attribute__((address_space(1))) float gf32_t;
    Params q;
#pragma unroll
    for (int i = 0; i < 47; ++i) q.in[i] = (const float*)(const gf32_t*)(uintptr_t)p.in[i];
    q.out = (float*)(gf32_t*)(uintptr_t)p.out;
    q.ws = (unsigned char*)(gu8_t*)(uintptr_t)p.ws;
    uintptr_t ws_i = (uintptr_t)p.ws, out_i = (uintptr_t)p.out;
#define LND() do { asm volatile("" : "+s"(ws_i), "+s"(out_i) :: "memory"); q.ws = (unsigned char*)(gu8_t*)ws_i; q.out = (float*)(gf32_t*)out_i; } while (0)
    phase_mod(q, lds);
#pragma unroll 1
    for (int l = 0; l < 2; ++l) {
        LND();
        if (blockIdx.x == 0 && threadIdx.x < 64) ((int*)(q.ws + OFF_CNT))[threadIdx.x] = 0;
        phase_wconv(q, l, lds);
        LND();
        phase_hyf1(q, l);
        xcd_barrier(bar);
        LND();
        phase_hx(q, l);
        LND();
        phase_hyf2(q, l);
        xcd_barrier(bar);
        LND();
        phase_inproj(q, l, lds);
        LND();
        phase_hyf3(q, l, lds);
        xcd_barrier(bar);
        LND();
        stage_mixA(q, l, lds, role);
        xcd_barrier(bar);
        LND();
        stage_mixB(q, l, lds);
        xcd_barrier(bar);
        LND();
        stage_mixC(q, l, lds);
        xcd_barrier(bar);
        LND();
        stage_mixD(q, l, lds);
        xcd_barrier(bar);
        LND();
        phase_merge(q, l, lds);
        xcd_barrier(bar);
        LND();
        phase_wout(q, l, lds);
        LND();
        phase_wconv_moe(q, l, lds);
        xcd_barrier(bar);
        LND();
        phase_route(q, l, lds);
        xcd_barrier(bar);
        LND();
        phase_lists(q, l, lds);
        xcd_barrier(bar);
        LND();
        phase_moe_up(q, lds);
        xcd_barrier(bar);
        LND();
        phase_moe_down(q, lds);
        xcd_barrier(bar);
        LND();
        phase_combine(q, l);
    }
#undef LND
}

extern "C" void kernel_launch(void* const* d_in, const int* in_sizes, int n_in, void* d_out, int out_size, void* d_ws, size_t ws_size, hipStream_t stream) {
    (void)in_sizes; (void)out_size;
    if (n_in < 47 || ws_size < WS_NEED) { fprintf(stderr, "kernel_launch: bad inputs (n_in %d, ws %zu < %zu)\n", n_in, ws_size, (size_t)WS_NEED); return; }
    static int grid = 0;
    if (!grid) {
        int dev = 0, cus = 0, per_cu = 0;
        hipGetDevice(&dev);
        hipDeviceGetAttribute(&cus, hipDeviceAttributeMultiprocessorCount, dev);
        hipFuncSetAttribute((const void*)fwd_kernel, hipFuncAttributeMaxDynamicSharedMemorySize, LDS_BYTES);
        hipOccupancyMaxActiveBlocksPerMultiprocessor(&per_cu, fwd_kernel, NTHR, LDS_BYTES);
        if (per_cu > 2) per_cu = 2;
        if (per_cu < 1) per_cu = 1;
        grid = cus * per_cu;
    }
    hipMemsetAsync(d_ws, 0, OFF_CUSLOT + 2048 * sizeof(int), stream);
    Params p{};
    for (int i = 0; i < 47; ++i) p.in[i] = (const float*)d_in[i];
    p.out = (float*)d_out;
    p.ws = (unsigned char*)d_ws;
    hipLaunchKernelGGL(fwd_kernel, dim3(grid), dim3(NTHR), LDS_BYTES, stream, p);
}
```
